# Optimizing an MI355X kernel written in HIP

```python
import math
import jax, jax.numpy as jnp
from jax import lax
import numpy as np


D_MODEL = 1024
BATCH = 2
SEQ = 16384
DEPTH = 4

GRID_W = 64
CTX_LEN = 256
N_MIXERS = 4
D_MIX = D_MODEL
GROUP_W = D_MIX // N_MIXERS
POOL_WINDOWS = (2, 4, 8, 16)
POOL_GROUPS = 4
POOL_GW = GROUP_W // POOL_GROUPS
FOURIER_GROUPS = 4
FOURIER_GW = GROUP_W // FOURIER_GROUPS
CONV_K = 31
GDN_HEAD_DIM = 64
GDN_HEADS = GROUP_W // GDN_HEAD_DIM
GDN_CONV = 3
GDN_CHUNK = 64
FFN_HIDDEN = 128 * ((8 * D_MODEL // 3 + 127) // 128)
N_MOD = 9
EPS = 1e-6
POOL_OFF = 0
FOURIER_OFF = POOL_OFF + GROUP_W
CONV_OFF = FOURIER_OFF + GROUP_W
GDN_OFF = CONV_OFF + 2 * GROUP_W
GDN_PROJ = 4 * GROUP_W + 4 * GDN_HEADS
PROJ_W = GDN_OFF + GDN_PROJ

kernel_name = 'hybrid_parallel_group_dit_block'


def _rms(x, w):
    xf = x.astype(jnp.float32)
    y = xf * lax.rsqrt(jnp.mean(xf * xf, axis=-1, keepdims=True) + EPS)
    return (y * w.astype(jnp.float32)).astype(x.dtype)


def _modulate(n, shift, scale):
    return n * (1 + scale) + shift


def _swiglu(n, wg, wu, wd):
    return (jax.nn.silu(n @ wg) * (n @ wu)) @ wd


def _dwconv(x, w, pad):
    ch = x.shape[-1]
    filt = w[:, None, :].astype(x.dtype)
    return lax.conv_general_dilated(x, filt, (1,), [(pad, pad)],
                                    dimension_numbers=('NWC', 'WIO', 'NWC'),
                                    feature_group_count=ch)


def _window_bounds(n, w):
    t = jnp.arange(n)
    return jnp.clip(t - w // 2, 0, n), jnp.clip(t + w - w // 2, 0, n)


def _pool_means_seq(u):
    n = u.shape[1]
    p = jnp.pad(jnp.cumsum(u.astype(jnp.float32), axis=1), ((0, 0), (1, 0), (0, 0)))
    outs = []
    for gi, w in enumerate(POOL_WINDOWS):
        pg = p[..., gi * POOL_GW:(gi + 1) * POOL_GW]
        lo, hi = _window_bounds(n, w)
        cnt = (hi - lo).astype(jnp.float32)
        outs.append((pg[:, hi] - pg[:, lo]) / cnt[None, :, None])
    return jnp.concatenate(outs, axis=-1)


def _pool_means_grid(u, rows):
    bsz, n, ch = u.shape
    uf = u.astype(jnp.float32).reshape(bsz, rows, GRID_W, ch)
    p = jnp.pad(jnp.cumsum(jnp.cumsum(uf, axis=1), axis=2), ((0, 0), (1, 0), (1, 0), (0, 0)))
    outs = []
    for gi, w in enumerate(POOL_WINDOWS):
        pg = p[..., gi * POOL_GW:(gi + 1) * POOL_GW]
        r0, r1 = _window_bounds(rows, w)
        c0, c1 = _window_bounds(GRID_W, w)
        s = (pg[:, r1][:, :, c1] - pg[:, r0][:, :, c1]
             - pg[:, r1][:, :, c0] + pg[:, r0][:, :, c0])
        cnt = ((r1 - r0)[:, None] * (c1 - c0)[None, :]).astype(jnp.float32)
        outs.append(s / cnt[None, :, :, None])
    return jnp.concatenate(outs, axis=-1).reshape(bsz, n, ch)


def _pool_mixer(u, mean, pool_w, pool_scale):
    bsz, n, _ = u.shape
    d = (mean - u.astype(jnp.float32)).astype(u.dtype).reshape(bsz, n, POOL_GROUPS, POOL_GW)
    y = jnp.einsum('bngc,gcd->bngd', d, pool_w).reshape(bsz, n, GROUP_W)
    return y * pool_scale


def _fourier_mixer(u, fourier_w):
    bsz, n, _ = u.shape
    uf = u.astype(jnp.float32).reshape(bsz, n, FOURIER_GROUPS, FOURIER_GW)
    f = jnp.fft.fft2(uf, axes=(1, 3), norm='ortho').real.reshape(bsz, n, GROUP_W)
    return f.astype(u.dtype) @ fourier_w


def _conformer_conv(u2, dw_w, dw_b, ln_g, ln_b, pw_w):
    a, b = jnp.split(u2, 2, axis=-1)
    h = _dwconv(a * jax.nn.sigmoid(b), dw_w, CONV_K // 2) + dw_b
    hf = h.astype(jnp.float32)
    mu = jnp.mean(hf, axis=-1, keepdims=True)
    var = jnp.mean(jnp.square(hf - mu), axis=-1, keepdims=True)
    h = ((hf - mu) * lax.rsqrt(var + EPS) * ln_g.astype(jnp.float32) + ln_b.astype(jnp.float32)).astype(u2.dtype)
    return jax.nn.silu(h) @ pw_w


def _l2norm(t):
    return t * lax.rsqrt(jnp.sum(t * t, axis=-1, keepdims=True) + EPS)


def _gated_delta_chunked(q, k, v, g, beta, s0):
    bsz, n, h, _ = q.shape
    dv = v.shape[-1]
    nc = n // GDN_CHUNK

    def blk(t):
        t = t.reshape((bsz, nc, GDN_CHUNK, h) + t.shape[3:])
        return jnp.moveaxis(t, (1, 3), (0, 2))

    qb, kb, vb, gb, bb = blk(q), blk(k), blk(v), blk(g), blk(beta)
    gc = jnp.cumsum(gb, axis=-1)
    idx = jnp.arange(GDN_CHUNK)
    incl = idx[:, None] >= idx[None, :]
    strict = idx[:, None] > idx[None, :]
    gam = jnp.exp(jnp.where(incl, gc[..., :, None] - gc[..., None, :], -jnp.inf))
    kbeta = kb * bb[..., None]
    m = jnp.where(strict, jnp.einsum('nbhik,nbhjk->nbhij', kbeta, kb) * gam, 0.0)
    a = m + jnp.eye(GDN_CHUNK, dtype=m.dtype)
    rhs = jnp.concatenate([vb * bb[..., None], kbeta * jnp.exp(gc)[..., None]], axis=-1)
    sol = lax.linalg.triangular_solve(a, rhs, left_side=True, lower=True, unit_diagonal=True)
    u, w = sol[..., :dv], sol[..., dv:]
    aqk = jnp.einsum('nbhik,nbhjk->nbhij', qb, kb) * gam
    qdec = qb * jnp.exp(gc)[..., None]
    glast = gc[..., -1]
    kdec = kb * jnp.exp(glast[..., None] - gc)[..., None]

    def step(s, xs):
        u_i, w_i, q_i, k_i, a_i, gl_i = xs
        v_new = u_i - jnp.einsum('bhck,bhkv->bhcv', w_i, s)
        o_i = jnp.einsum('bhck,bhkv->bhcv', q_i, s) + jnp.einsum('bhij,bhjv->bhiv', a_i, v_new)
        s = s * jnp.exp(gl_i)[..., None, None] + jnp.einsum('bhck,bhcv->bhkv', k_i, v_new)
        return s, o_i

    s_fin, o = lax.scan(step, s0, (u, w, qdec, kdec, aqk, glast))
    o = jnp.moveaxis(o, (0, 2), (1, 3)).reshape(bsz, n, h, dv)
    return o, s_fin


def _gdn_inputs(p, conv_w, a_log, dt_bias):
    bsz, n, _ = p.shape
    qkv = jax.nn.silu(_dwconv(p[..., :3 * GROUP_W], conv_w, GDN_CONV // 2)).astype(jnp.float32)
    q, k, v = jnp.split(qkv.reshape(bsz, n, 3, GDN_HEADS, GDN_HEAD_DIM), 3, axis=2)
    q = _l2norm(q[:, :, 0]) * (GDN_HEAD_DIM ** -0.5)
    k = _l2norm(k[:, :, 0])
    v = v[:, :, 0]
    z = p[..., 3 * GROUP_W:4 * GROUP_W]
    off = 4 * GROUP_W
    a = p[..., off:off + 2 * GDN_HEADS].astype(jnp.float32).reshape(bsz, n, 2, GDN_HEADS)
    b = p[..., off + 2 * GDN_HEADS:off + 4 * GDN_HEADS].astype(jnp.float32).reshape(bsz, n, 2, GDN_HEADS)
    g = -jnp.exp(a_log.astype(jnp.float32)) * jax.nn.softplus(a + dt_bias.astype(jnp.float32))
    return q, k, v, z, g, jax.nn.sigmoid(b)


def _gated_out(o, z, w):
    zf = z.astype(jnp.float32).reshape(o.shape)
    y = o * lax.rsqrt(jnp.mean(o * o, axis=-1, keepdims=True) + EPS) * w.astype(jnp.float32) * jax.nn.silu(zf)
    return y.reshape(o.shape[0], o.shape[1], -1).astype(z.dtype)


def _gdn_mixer(p_x, p_c, need_ctx, conv_w, a_log, dt_bias, norm_w):
    qc, kc, vc, zc, gc, bc = _gdn_inputs(p_c, conv_w, a_log, dt_bias)
    qx, kx, vx, zx, gx, bx = _gdn_inputs(p_x, conv_w, a_log, dt_bias)
    s0 = jnp.zeros((p_x.shape[0], GDN_HEADS, GDN_HEAD_DIM, GDN_HEAD_DIM), jnp.float32)
    fl = lambda t: jnp.flip(t, axis=1)
    oc_f, sc_f = _gated_delta_chunked(qc, kc, vc, gc[:, :, 0], bc[:, :, 0], s0)
    oc_b, sc_b = _gated_delta_chunked(fl(qc), fl(kc), fl(vc), fl(gc[:, :, 1]), fl(bc[:, :, 1]), s0)
    ox_f, _ = _gated_delta_chunked(qx, kx, vx, gx[:, :, 0], bx[:, :, 0], sc_f)
    ox_b, _ = _gated_delta_chunked(fl(qx), fl(kx), fl(vx), fl(gx[:, :, 1]), fl(bx[:, :, 1]), sc_b)
    yx = _gated_out(ox_f + fl(ox_b), zx, norm_w)
    yc = _gated_out(oc_f + fl(oc_b), zc, norm_w) if need_ctx else None
    return yx, yc


def _token_mixer(nx, nc, rows, need_ctx, w_in, w_out, pool_w, pool_scale, fourier_w,
                 conv_dw_w, conv_dw_b, conv_ln_g, conv_ln_b, conv_pw_w,
                 gdn_conv_w, gdn_a_log, gdn_dt_bias, gdn_norm_w):
    px = nx @ w_in
    pc = nc @ (w_in if need_ctx else w_in[:, GDN_OFF:])
    pc_gdn = pc[..., GDN_OFF:] if need_ctx else pc
    gdn_x, gdn_c = _gdn_mixer(px[..., GDN_OFF:], pc_gdn, need_ctx, gdn_conv_w, gdn_a_log, gdn_dt_bias, gdn_norm_w)

    def local_groups(p, pool_mean):
        u_pool = p[..., POOL_OFF:FOURIER_OFF]
        return [_pool_mixer(u_pool, pool_mean(u_pool), pool_w, pool_scale),
                _fourier_mixer(p[..., FOURIER_OFF:CONV_OFF], fourier_w),
                _conformer_conv(p[..., CONV_OFF:GDN_OFF], conv_dw_w, conv_dw_b, conv_ln_g, conv_ln_b, conv_pw_w)]

    yx = jnp.concatenate(local_groups(px, lambda u: _pool_means_grid(u, rows)) + [gdn_x], axis=-1) @ w_out
    yc = (jnp.concatenate(local_groups(pc, _pool_means_seq) + [gdn_c], axis=-1) @ w_out) if need_ctx else None
    return yx, yc


def setup_inputs(seed: int = 0) -> dict:
    key = jax.random.key(seed)
    ks = jax.random.split(key, 32)
    f32 = jnp.float32
    L, D, F, G, H = DEPTH, D_MODEL, FFN_HIDDEN, GROUP_W, GDN_HEADS

    def nrm(k, shape, scale):
        return scale * jax.random.normal(k, shape, f32)

    dt = jnp.exp(jax.random.uniform(ks[26], (L, 2, H), f32, math.log(1e-3), math.log(1e-1)))
    return {
        'x': nrm(ks[0], (BATCH, SEQ, D), 1.0),
        'c': nrm(ks[1], (BATCH, D), 1.0),
        'ctx': nrm(ks[2], (BATCH, CTX_LEN, D), 1.0),
        'c_ctx': nrm(ks[3], (D,), 1.0),
        'mod_w': nrm(ks[4], (L, D, N_MOD * D), 0.5 * D ** -0.5),
        'mod_b': nrm(ks[5], (L, N_MOD * D), 0.02),
        'norm_w': 1.0 + nrm(ks[6], (L, 3, D), 0.02),
        'ffn1_wg': nrm(ks[7], (L, D, F), D ** -0.5),
        'ffn1_wu': nrm(ks[8], (L, D, F), D ** -0.5),
        'ffn1_wd': nrm(ks[9], (L, F, D), F ** -0.5),
        'ffn2_wg': nrm(ks[10], (L, D, F), D ** -0.5),
        'ffn2_wu': nrm(ks[11], (L, D, F), D ** -0.5),
        'ffn2_wd': nrm(ks[12], (L, F, D), F ** -0.5),
        'w_in': nrm(ks[13], (L, D, PROJ_W), D ** -0.5),
        'w_out': nrm(ks[14], (L, D_MIX, D), D_MIX ** -0.5),
        'pool_w': nrm(ks[15], (L, POOL_GROUPS, POOL_GW, POOL_GW), POOL_GW ** -0.5),
        'pool_scale': 1.0 + nrm(ks[16], (L, G), 0.1),
        'fourier_w': nrm(ks[17], (L, G, G), G ** -0.5),
        'conv_dw_w': nrm(ks[18], (L, CONV_K, G), CONV_K ** -0.5),
        'conv_dw_b': nrm(ks[19], (L, G), 0.02),
        'conv_ln_g': 1.0 + nrm(ks[20], (L, G), 0.02),
        'conv_ln_b': nrm(ks[21], (L, G), 0.02),
        'conv_pw_w': nrm(ks[22], (L, G, G), G ** -0.5),
        'gdn_conv_w': nrm(ks[23], (L, GDN_CONV, 3 * G), GDN_CONV ** -0.5),
        'gdn_a_log': jnp.log(jax.random.uniform(ks[24], (L, 2, H), f32, 1.0, 16.0)),
        'gdn_dt_bias': dt + jnp.log(-jnp.expm1(-dt)),
        'gdn_norm_w': 1.0 + nrm(ks[25], (L, GDN_HEAD_DIM), 0.02),
        'final_norm_w': 1.0 + nrm(ks[27], (D,), 0.02),
    }


def reference(x, c, ctx, c_ctx, mod_w, mod_b, norm_w, ffn1_wg, ffn1_wu, ffn1_wd,
              ffn2_wg, ffn2_wu, ffn2_wd, w_in, w_out, pool_w, pool_scale, fourier_w,
              conv_dw_w, conv_dw_b, conv_ln_g, conv_ln_b, conv_pw_w,
              gdn_conv_w, gdn_a_log, gdn_dt_bias, gdn_norm_w, final_norm_w):
    rows = x.shape[1] // GRID_W
    hx, hc = x, ctx
    cs = jax.nn.silu(c)
    ccs = jax.nn.silu(c_ctx)
    for l in range(DEPTH):
        last = l == DEPTH - 1
        mx = jnp.split((cs @ mod_w[l] + mod_b[l])[:, None, :], N_MOD, axis=-1)
        mc = jnp.split(ccs @ mod_w[l] + mod_b[l], N_MOD, axis=-1)
        f1 = (ffn1_wg[l], ffn1_wu[l], ffn1_wd[l])
        f2 = (ffn2_wg[l], ffn2_wu[l], ffn2_wd[l])
        hx = hx + 0.5 * mx[2] * _swiglu(_modulate(_rms(hx, norm_w[l, 0]), mx[0], mx[1]), *f1)
        hc = hc + 0.5 * mc[2] * _swiglu(_modulate(_rms(hc, norm_w[l, 0]), mc[0], mc[1]), *f1)
        nx = _modulate(_rms(hx, norm_w[l, 1]), mx[3], mx[4])
        nc = _modulate(_rms(hc, norm_w[l, 1]), mc[3], mc[4])
        yx, yc = _token_mixer(nx, nc, rows, not last, w_in[l], w_out[l], pool_w[l], pool_scale[l],
                              fourier_w[l], conv_dw_w[l], conv_dw_b[l], conv_ln_g[l], conv_ln_b[l],
                              conv_pw_w[l], gdn_conv_w[l], gdn_a_log[l], gdn_dt_bias[l], gdn_norm_w[l])
        hx = hx + mx[5] * yx
        hx = hx + 0.5 * mx[8] * _swiglu(_modulate(_rms(hx, norm_w[l, 2]), mx[6], mx[7]), *f2)
        if not last:
            hc = hc + mc[5] * yc
            hc = hc + 0.5 * mc[8] * _swiglu(_modulate(_rms(hc, norm_w[l, 2]), mc[6], mc[7]), *f2)
    return _rms(hx, final_norm_w)
```

```cpp
#define M2_CONV 1
#define M2_POOL 1
#include <hip/hip_runtime.h>
#include <hip/hip_cooperative_groups.h>
#include <cstdio>
namespace cg = cooperative_groups;
#define DEVI __device__ __forceinline__
namespace pg8 {
#define PG8_LAS __attribute__((address_space(3)))
typedef unsigned short bf16_t;
typedef short bf16x8 __attribute__((ext_vector_type(8)));
typedef float f32x4 __attribute__((ext_vector_type(4)));
typedef unsigned u32x4 __attribute__((ext_vector_type(4)));
constexpr int BM = 256, BK = 64, HALF = 128, HTB = HALF * BK * 2  , STAGE_BYTES = 8 * HTB, NXCD = 8, WGM = 8;

__host__ __device__ __forceinline__ int lds_byte(int r, int c) { const int st = (r >> 4) * 2 + (c >> 5), rr = r & 15, cc = c & 31, ob = rr * 64 + cc * 2; return st * 1024 + (ob ^ (((ob >> 9) & 1) << 5)); }
__host__ __device__ __forceinline__ void stage_rc(int b, int& R, int& C) { const int st = b / 1024, sb = b % 1024, swz = sb ^ (((sb >> 9) & 1) << 5); R = (st >> 1) * 16 + swz / 64; C = (st & 1) * 32 + (swz % 64) / 2; }
__host__ __device__ __forceinline__ int perm32(int rho) { const int n = rho >> 4, i = rho & 15; return 8 * (i >> 2) + 4 * n + (i & 3); }

struct Unit { int pm, pn; };
struct Gemm { const bf16_t* A; const bf16_t* Bt; int M, N, K; };
struct StaticOrder {
    int nM, nN, nwg, G, c;
    __host__ __device__ void init(int M, int N, int G_, int c_) { nM = M / BM; nN = N / BM; nwg = nM * nN; G = G_; c = c_; }
    __host__ __device__ bool next(int i, Unit& u) const {
        const long L = (long)i * G + c; if (L >= nwg) return false;
        int wgid = (int)L; { const int q = nwg / NXCD, r = nwg % NXCD, xcd = wgid % NXCD, off = wgid / NXCD; wgid = (xcd < r ? xcd * (q + 1) : r * (q + 1) + (xcd - r) * q) + off; }
        const int nig = WGM * nN, gid = wgid / nig, fm = gid * WGM, gsz = (nM - fm) < WGM ? (nM - fm) : WGM;
        u.pm = fm + ((wgid % nig) % gsz); u.pn = (wgid % nig) / gsz; return true;
    }
    __device__ __forceinline__ void a_ready(const Unit&) const {}
    __device__ __forceinline__ void done(const Unit&) const {}
};
__device__ __forceinline__ unsigned cvt_pk_bf16(float lo, float hi) { unsigned r; asm volatile("v_cvt_pk_bf16_f32 %0, %1, %2" : "=v"(r) : "v"(lo), "v"(hi)); return r; }
template <class Epi, class Sched, bool ALIGN_EPI = false, bool SP2 = false>
__device__ __forceinline__ void gemm_phase(PG8_LAS unsigned char* lds, const Gemm g, const Sched& S, const Epi& E) {
    int tid_ = threadIdx.x; asm volatile("" : "+v"(tid_));
    const int tid = tid_, wid = __builtin_amdgcn_readfirstlane(tid >> 6), lane = tid & 63, wr = wid >> 2, wc = wid & 3, fr = lane & 15, fq = lane >> 4;
    const int K = g.K, nt = K / BK;
    unsigned voffA[2], voffB[2];
#pragma unroll
    for (int i = 0; i < 2; ++i) { int R, C; stage_rc(tid * 16 + i * 8192, R, C); const int Rb = Epi::PERM ? ((R & ~31) + perm32(R & 31)) : R;
        voffA[i] = (unsigned)(R * K + C) * 2u; voffB[i] = (unsigned)(Rb * K + C) * 2u; }
    const size_t kstep = (size_t)(BK * 2);
    const size_t hstep = (size_t)HALF * K * 2;
    const size_t tstep = 2 * hstep;
    const unsigned ldsw = (unsigned)wid * 1024u;
    const int aoff = lds_byte(wr * 64 + fr, fq * 8), boff = lds_byte(wc * 32 + fr, fq * 8);
#define PG8_SA(b, h) (((b) * 2 + (h)) * HTB)
#define PG8_SB(b, h) ((4 + (b) * 2 + (h)) * HTB)
#define PG8_STAGE(bufoff, gbase, voff) do { _Pragma("unroll") for (int _i = 0; _i < 2; ++_i) \
        __builtin_amdgcn_global_load_lds((const unsigned*)((const char*)(gbase) + (voff)[_i]), (PG8_LAS unsigned*)(lds + (bufoff) + ldsw + _i * 8192), 16, 0, 0); } while (0)
#define PG8_LDA(dst, b, h) do { _Pragma("unroll") for (int m = 0; m < 4; ++m) _Pragma("unroll") for (int k = 0; k < 2; ++k) dst[m][k] = *(const PG8_LAS bf16x8*)(lds + PG8_SA(b, h) + aoff + m * 2048 + k * 1024); } while (0)
#define PG8_LDB(dst, b, h) do { _Pragma("unroll") for (int n = 0; n < 2; ++n) _Pragma("unroll") for (int k = 0; k < 2; ++k) dst[n][k] = *(const PG8_LAS bf16x8*)(lds + PG8_SB(b, h) + boff + n * 2048 + k * 1024); } while (0)
#define PG8_MMA(ai, bj, At, Bt) do { __builtin_amdgcn_s_setprio(1); _Pragma("unroll") for (int m = 0; m < 4; ++m) _Pragma("unroll") for (int n = 0; n < 2; ++n) _Pragma("unroll") for (int k = 0; k < 2; ++k) \
        acc[ai][bj][m][n] = __builtin_amdgcn_mfma_f32_16x16x32_bf16(Bt[n][k], At[m][k], acc[ai][bj][m][n], 0, 0, 0); __builtin_amdgcn_s_setprio(0); } while (0)
#define PG8_WAIT_V(n) asm volatile("s_waitcnt vmcnt(" #n ")" ::: "memory")
#define PG8_WAIT_L(n) asm volatile("s_waitcnt lgkmcnt(" #n ")" ::: "memory")
#define PG8_BAR __builtin_amdgcn_s_barrier()
#define PG8_SCHED __builtin_amdgcn_sched_barrier(0)
    Unit cur, nxt; int ui = 0;
    if (!S.next(0, cur)) return;
    f32x4 acc[2][2][4][2];
#pragma unroll
    for (int a = 0; a < 2; ++a)
#pragma unroll
        for (int b = 0; b < 2; ++b)
#pragma unroll
            for (int m = 0; m < 4; ++m)
#pragma unroll
                for (int n = 0; n < 2; ++n) acc[a][b][m][n] = (f32x4){0.f, 0.f, 0.f, 0.f};
    bf16x8 At[4][2], B0[2][2], B1[2][2];
    const char* cA = (const char*)g.A + (size_t)cur.pm * tstep; const char* cB = (const char*)g.Bt + (size_t)cur.pn * tstep;
    S.a_ready(cur);
    if constexpr (SP2) {
        PG8_STAGE(PG8_SB(0, 0), cB, voffB); PG8_STAGE(PG8_SB(0, 1), cB + hstep, voffB); PG8_STAGE(PG8_SA(0, 0), cA, voffA); PG8_STAGE(PG8_SA(0, 1), cA + hstep, voffA);
        if (wr == 1) PG8_BAR;
        PG8_WAIT_V(2); PG8_BAR;
        PG8_STAGE(PG8_SB(1, 0), cB + kstep, voffB); PG8_STAGE(PG8_SA(1, 0), cA + kstep, voffA); PG8_STAGE(PG8_SB(1, 1), cB + hstep + kstep, voffB);
        PG8_WAIT_V(6); PG8_BAR;
    } else {
        PG8_STAGE(PG8_SB(0, 0), cB, voffB); PG8_STAGE(PG8_SA(0, 0), cA, voffA); PG8_STAGE(PG8_SB(0, 1), cB + hstep, voffB); PG8_STAGE(PG8_SA(0, 1), cA + hstep, voffA);
        if (wr == 1) PG8_BAR;
        PG8_WAIT_V(4); PG8_BAR;
        PG8_STAGE(PG8_SB(1, 0), cB + kstep, voffB); PG8_STAGE(PG8_SA(1, 0), cA + kstep, voffA); PG8_STAGE(PG8_SB(1, 1), cB + hstep + kstep, voffB);
        PG8_WAIT_V(6); PG8_BAR;
    }
    for (;;) {
        const bool has_next = S.next(ui + 1, nxt);
        const char* nA = has_next ? (const char*)g.A + (size_t)nxt.pm * tstep : cA; const char* nB = has_next ? (const char*)g.Bt + (size_t)nxt.pn * tstep : cB;
        for (int t = 0; t < nt; t += 2) {
            const bool last = (t == nt - 2);
            const char* a1 = cA + (size_t)(t + 1) * kstep;
            const char* a2 = last ? nA : cA + (size_t)(t + 2) * kstep; const char* b2 = last ? nB : cB + (size_t)(t + 2) * kstep;
            const char* a3 = a2 + kstep; const char* b3 = b2 + kstep;
            if (last && has_next) S.a_ready(nxt);
            if constexpr (SP2) {
            PG8_LDB(B0, 0, 0); PG8_LDB(B1, 0, 1); PG8_SCHED; PG8_LDA(At, 0, 0); PG8_STAGE(PG8_SA(1, 1), a1 + hstep, voffA);
            PG8_WAIT_V(8); PG8_WAIT_L(0); PG8_BAR; PG8_MMA(0, 0, At, B0); PG8_MMA(0, 1, At, B1); PG8_BAR; PG8_SCHED;
            PG8_LDA(At, 0, 1); PG8_STAGE(PG8_SB(0, 0), b2, voffB); PG8_STAGE(PG8_SB(0, 1), b2 + hstep, voffB); PG8_STAGE(PG8_SA(0, 0), a2, voffA);
            PG8_WAIT_V(8); PG8_WAIT_L(0); PG8_BAR; PG8_MMA(1, 0, At, B0); PG8_MMA(1, 1, At, B1); PG8_BAR; PG8_SCHED;
            PG8_LDB(B0, 1, 0); PG8_LDB(B1, 1, 1); PG8_SCHED; PG8_LDA(At, 1, 0); PG8_STAGE(PG8_SA(0, 1), a2 + hstep, voffA);
            PG8_WAIT_V(8); PG8_WAIT_L(0); PG8_BAR; PG8_MMA(0, 0, At, B0); PG8_MMA(0, 1, At, B1); PG8_BAR; PG8_SCHED;
            PG8_LDA(At, 1, 1); PG8_STAGE(PG8_SB(1, 0), b3, voffB); PG8_STAGE(PG8_SB(1, 1), b3 + hstep, voffB); PG8_STAGE(PG8_SA(1, 0), a3, voffA);
            PG8_WAIT_V(8); PG8_WAIT_L(0); PG8_BAR; PG8_MMA(1, 0, At, B0); PG8_MMA(1, 1, At, B1); PG8_BAR; PG8_SCHED;
            } else {
            PG8_LDB(B0, 0, 0); PG8_SCHED; PG8_LDA(At, 0, 0); PG8_STAGE(PG8_SA(1, 1), a1 + hstep, voffA);
            PG8_WAIT_L(8); PG8_BAR; PG8_WAIT_L(0); PG8_MMA(0, 0, At, B0); PG8_BAR; PG8_SCHED;
            PG8_LDB(B1, 0, 1); PG8_STAGE(PG8_SB(0, 0), b2, voffB);
            PG8_BAR; PG8_WAIT_L(0); PG8_MMA(0, 1, At, B1); PG8_BAR;
            PG8_LDA(At, 0, 1); PG8_STAGE(PG8_SA(0, 0), a2, voffA);
            PG8_BAR; PG8_WAIT_L(0); PG8_MMA(1, 0, At, B0); PG8_BAR; PG8_SCHED;
            PG8_STAGE(PG8_SB(0, 1), b2 + hstep, voffB);
            PG8_WAIT_V(6); PG8_BAR; PG8_MMA(1, 1, At, B1); PG8_BAR;
            PG8_LDB(B0, 1, 0); PG8_SCHED; PG8_LDA(At, 1, 0); PG8_STAGE(PG8_SA(0, 1), a2 + hstep, voffA);
            PG8_WAIT_L(8); PG8_BAR; PG8_WAIT_L(0); PG8_MMA(0, 0, At, B0); PG8_BAR; PG8_SCHED;
            PG8_LDB(B1, 1, 1); PG8_STAGE(PG8_SB(1, 0), b3, voffB);
            PG8_BAR; PG8_WAIT_L(0); PG8_MMA(0, 1, At, B1); PG8_BAR;
            PG8_LDA(At, 1, 1); PG8_STAGE(PG8_SA(1, 0), a3, voffA);
            PG8_BAR; PG8_WAIT_L(0); PG8_MMA(1, 0, At, B0); PG8_BAR; PG8_SCHED;
            PG8_STAGE(PG8_SB(1, 1), b3 + hstep, voffB);
            PG8_WAIT_V(6); PG8_BAR; PG8_MMA(1, 1, At, B1); PG8_BAR;
            }
        }
        if constexpr (ALIGN_EPI) { if (wr == 0) PG8_BAR; }
        if constexpr (!Epi::AFTER_DRAIN) { E(acc, cur, wr, wc, fr, fq); S.done(cur); }
        if (!has_next) break;
#pragma unroll
        for (int a = 0; a < 2; ++a)
#pragma unroll
            for (int b = 0; b < 2; ++b)
#pragma unroll
                for (int m = 0; m < 4; ++m)
#pragma unroll
                    for (int n = 0; n < 2; ++n) acc[a][b][m][n] = (f32x4){0.f, 0.f, 0.f, 0.f};
        cur = nxt; cA = nA; cB = nB; ++ui;
        if constexpr (ALIGN_EPI) { if (wr == 1) PG8_BAR; }
    }
    PG8_WAIT_V(0);
    if constexpr (!ALIGN_EPI) { if (wr == 0) PG8_BAR; }
    PG8_BAR;
    if constexpr (Epi::AFTER_DRAIN) { E.fused(acc, cur, wr, wc, fr, fq, lds, wid, lane); S.done(cur); }
#undef PG8_SA
#undef PG8_SB
#undef PG8_STAGE
#undef PG8_LDA
#undef PG8_LDB
#undef PG8_MMA
#undef PG8_WAIT_V
#undef PG8_WAIT_L
#undef PG8_BAR
#undef PG8_SCHED
}
}
#ifndef SKIPM
#define SKIPM 0
#endif
#ifndef REPM
#define REPM 0
#endif
using pg8::bf16_t; using pg8::f32x4; using pg8::u32x4; using pg8::Unit;

constexpr int D = 1024, SEQ = 16384, T = 32768, TC = 512, MROWS = 33280, FH = 2816, NLAYER = 4;
constexpr int PPITCH = 2080, PN = 2304, YK = 1280, NCH = 260;
constexpr float EPS = 1e-6f;
constexpr size_t WS_WUP1 = 0;
constexpr size_t WS_WDN1 = WS_WUP1 + (size_t)5632 * 1024 * 2;
constexpr size_t WS_WUP2 = WS_WDN1 + (size_t)1024 * 2816 * 2;
constexpr size_t WS_WDN2 = WS_WUP2 + (size_t)5632 * 1024 * 2;
constexpr size_t WS_WIN  = WS_WDN2 + (size_t)1024 * 2816 * 2;
constexpr size_t WS_WOUT = WS_WIN + (size_t)PN * 1024 * 2;
constexpr size_t WS_MOD  = WS_WOUT + (size_t)1024 * YK * 2;
constexpr size_t WS_CF   = WS_MOD + (size_t)4 * 3 * 9216 * 4;
constexpr size_t WS_CTXR = WS_CF + (size_t)4 * 2 * 65536 * 4;
constexpr size_t WS_NY   = WS_CTXR + (size_t)TC * D * 4;
constexpr size_t WS_U    = WS_NY + (size_t)MROWS * YK * 2;
constexpr size_t WS_H    = WS_U;
constexpr size_t WS_P    = WS_U;
constexpr size_t WS_FS   = WS_P + (size_t)MROWS * PPITCH * 2;
constexpr size_t WS_GD   = WS_FS + (size_t)2 * 16384 * 256 * 8;
constexpr size_t GD_REC_F = 12288;
constexpr size_t WS_END  = WS_GD + (size_t)16 * NCH * GD_REC_F * 4;
static_assert(WS_U + (size_t)MROWS * FH * 2 <= WS_END, "H fits");
constexpr size_t WS_BAR = WS_END;
constexpr size_t WS_RS = WS_BAR + 16384;
constexpr size_t RS_STRIDE = (size_t)MROWS * 4;
constexpr size_t WS_BIAS = WS_RS + 3 * RS_STRIDE;
constexpr size_t WS_TOTAL = WS_BIAS + (size_t)3 * 3 * 5632 * 4;
constexpr int LDS_BYTES = 160 * 1024;
constexpr int TAB_OFF = 32768;

struct Params { const float* in[28]; float* out; unsigned char* ws; int ph_lo, ph_hi; };

#define GASP __attribute__((address_space(1)))
DEVI unsigned char* opq(unsigned char* x) { GASP unsigned char* g = (GASP unsigned char*)x; asm volatile("" : "+s"(g)); return (unsigned char*)g; }
DEVI const float* inp(const Params& p, int i) { asm volatile("" : "+s"(i)); GASP const float* g = (GASP const float*)p.in[i]; asm volatile("" : "+s"(g)); return (const float*)g; }
DEVI float* outp(const Params& p) { GASP float* g = (GASP float*)p.out; asm volatile("" : "+s"(g)); return (float*)g; }
DEVI int obx() { int b = blockIdx.x; asm volatile("" : "+s"(b)); return b; }
DEVI int ogd() { int b = gridDim.x; asm volatile("" : "+s"(b)); return b; }
DEVI int otid() { int t = threadIdx.x; asm volatile("" : "+v"(t)); return t; }
DEVI float bf2f(unsigned short b) { return __uint_as_float(((unsigned)b) << 16); }
DEVI unsigned pk2(float a, float b) { unsigned r; asm("v_cvt_pk_bf16_f32 %0, %1, %2" : "=v"(r) : "v"(a), "v"(b)); return r; }
DEVI unsigned short f2bf(float f) { return (unsigned short)(pk2(f, 0.f) & 0xFFFFu); }
DEVI float sigmf(float x) { return __builtin_amdgcn_rcpf(1.f + __expf(-x)); }
DEVI float siluf(float x) { return x * sigmf(x); }
DEVI float wave_sum(float v) {
#pragma unroll
    for (int o = 1; o < 64; o <<= 1) v += __shfl_xor(v, o);
    return v;
}
#define UNPACK8(v, f) do { (f)[0] = __uint_as_float((v).x << 16); (f)[1] = __uint_as_float((v).x & 0xFFFF0000u); (f)[2] = __uint_as_float((v).y << 16); (f)[3] = __uint_as_float((v).y & 0xFFFF0000u); \
    (f)[4] = __uint_as_float((v).z << 16); (f)[5] = __uint_as_float((v).z & 0xFFFF0000u); (f)[6] = __uint_as_float((v).w << 16); (f)[7] = __uint_as_float((v).w & 0xFFFF0000u); } while (0)
DEVI float* res_row(const Params& p, int row) { return row < T ? outp(p) + (size_t)row * D : (float*)(opq(p.ws) + WS_CTXR) + (size_t)(row - T) * D; }

DEVI void phase_init(const Params& p, float* sm) { unsigned char* const ws = opq(p.ws);
    const int tid = otid(), lane = tid & 63, wv = tid >> 6;
    const size_t gt = (size_t)obx() * 512 + tid, gs = (size_t)ogd() * 512;
    float* sv = sm;
    float* red = sm + 3072;
    float* tc = sm + 3072 + 1536;
    for (int i = tid; i < 3072; i += 512) { const float v = i < 2048 ? inp(p, 1)[i] : inp(p, 3)[i - 2048]; sv[i] = siluf(v); }
    if (tid < 64) { float s, c; sincospif((float)tid * (1.f / 32.f), &s, &c); tc[tid] = c; tc[64 + tid] = s; }
    __syncthreads();
    const float* mw = inp(p, 4); const float* mb = inp(p, 5); float* MOD = (float*)(ws + WS_MOD);
    for (int item = obx(); item < 576; item += ogd()) {
        const int gc = item * 64 + lane, l = gc / 9216, j = gc - l * 9216;
        const float* w = mw + ((size_t)l * 1024 + wv * 128) * 9216 + j;
        float a0 = 0.f, a1 = 0.f, a2 = 0.f;
#pragma unroll 8
        for (int k = 0; k < 128; ++k) { const float x = w[(size_t)k * 9216]; const int kk = wv * 128 + k; a0 += sv[kk] * x; a1 += sv[1024 + kk] * x; a2 += sv[2048 + kk] * x; }
        red[(wv * 3 + 0) * 64 + lane] = a0; red[(wv * 3 + 1) * 64 + lane] = a1; red[(wv * 3 + 2) * 64 + lane] = a2;
        __syncthreads();
        if (tid < 192) { const int r = tid >> 6; float s = mb[(size_t)l * 9216 + j];
#pragma unroll
            for (int w8 = 0; w8 < 8; ++w8) s += red[(w8 * 3 + r) * 64 + lane];
            MOD[((size_t)l * 3 + r) * 9216 + j] = s; }
        __syncthreads();
    }
    const float* fw = inp(p, 17); float* CF = (float*)(ws + WS_CF);
    for (size_t idx = gt; idx < 524288; idx += gs) {
        const int k = (int)(idx & 255), row = (int)((idx >> 8) & 255), t = (int)((idx >> 16) & 1), l = (int)(idx >> 17);
        const int g = row >> 6, c = row & 63;
        const float* f = fw + ((size_t)l * 256 + g * 64) * 256 + k; const float* tab = tc + t * 64; float s = 0.f;
        for (int m = 0; m < 64; ++m) s += tab[(c * m) & 63] * f[m * 256];
        CF[idx] = s;
    }
}

DEVI void transpose_wave(const float* src, int N, int k0, int n0, bf16_t* dst, int K, int drow0, float* scr, int lane) {
    float v[32]; const int n = n0 + (lane & 31);
#pragma unroll
    for (int i = 0; i < 32; ++i) v[i] = n < N ? src[(size_t)(k0 + 2 * i + (lane >> 5)) * N + n] : 0.f;
#pragma unroll
    for (int i = 0; i < 32; ++i) scr[(2 * i + (lane >> 5)) * 33 + (lane & 31)] = v[i];
    asm volatile("s_waitcnt lgkmcnt(0)" ::: "memory");
    const int c = lane & 7;
#pragma unroll
    for (int j = 0; j < 4; ++j) { const int nn = (lane >> 3) + 8 * j; const float* t = scr + (8 * c) * 33 + nn;
        uint4 o; o.x = pk2(t[0], t[33]); o.y = pk2(t[66], t[99]); o.z = pk2(t[132], t[165]); o.w = pk2(t[198], t[231]);
        *(uint4*)(dst + (size_t)(drow0 + nn) * K + k0 + 8 * c) = o; }
    asm volatile("s_waitcnt lgkmcnt(0)" ::: "memory");
}

DEVI void raw_rows(const Params& p) { unsigned char* const ws = opq(p.ws);
    const int tid = otid(); const int lane = tid & 63; const int gw = obx() * 8 + (tid >> 6), ngw = ogd() * 8;
    const float4* nw4 = (const float4*)inp(p, 6);
    const float* MOD = (const float*)(ws + WS_MOD);
    bf16_t* NY = (bf16_t*)(ws + WS_NY); float* RS0 = (float*)(ws + WS_RS);
    float4 w4[4];
#pragma unroll
    for (int q = 0; q < 4; ++q) w4[q] = nw4[lane + 64 * q];
    for (int row = gw; row < MROWS; row += ngw) {
        const float4* r4 = (const float4*)(row < T ? inp(p, 0) + (size_t)row * D : inp(p, 2) + (size_t)(row - T) * D); const int mr = row < SEQ ? 0 : (row < T ? 1 : 2);
        const float4* sc4 = (const float4*)(MOD + (size_t)mr * 9216 + 1024);
        float4 v[4]; float ss = 0.f;
#pragma unroll
        for (int q = 0; q < 4; ++q) { v[q] = r4[lane + 64 * q]; ss += v[q].x * v[q].x + v[q].y * v[q].y + v[q].z * v[q].z + v[q].w * v[q].w; }
        ss = wave_sum(ss); if (lane == 0) RS0[row] = ss;
#pragma unroll
        for (int q = 0; q < 4; ++q) { const float4 c = sc4[lane + 64 * q];
            uint2 o; o.x = pk2(v[q].x * w4[q].x * (1.f + c.x), v[q].y * w4[q].y * (1.f + c.y)); o.y = pk2(v[q].z * w4[q].z * (1.f + c.z), v[q].w * w4[q].w * (1.f + c.w));
            *(uint2*)(NY + (size_t)row * 1024 + (lane + 64 * q) * 4) = o; }
    }
}

DEVI void phase_prep(const Params& p, int l, float* sm) { unsigned char* const ws = opq(p.ws);
    const int tid = otid();
    constexpr int NT_UP = 16 * 88, NT_DN = 44 * 32, NT_IN = 16 * 65, TOTAL = 4 * NT_UP + 2 * NT_DN + NT_IN;
    { const int lane = tid & 63, wv = __builtin_amdgcn_readfirstlane(tid >> 6); float* scr = sm + wv * 2112;
      for (int it = obx() * 8 + wv; it < TOTAL; it += ogd() * 8) {
        int r = it;
        if (r < 4 * NT_UP) { const int which = r / NT_UP; r -= which * NT_UP; const int kt = r / 88, nt = r % 88;
            const float* src = inp(p, which == 0 ? 7 : which == 1 ? 8 : which == 2 ? 10 : 11) + (size_t)l * 1024 * FH;
            const int n0 = nt * 32, drow0 = 256 * (n0 >> 7) + 128 * (which & 1) + (n0 & 127);
            transpose_wave(src, FH, kt * 64, n0, (bf16_t*)(ws + ((which >> 1) ? WS_WUP2 : WS_WUP1)), 1024, drow0, scr, lane);
        } else if ((r -= 4 * NT_UP) < 2 * NT_DN) { const int which = r / NT_DN; r -= which * NT_DN; const int kt = r / 32, nt = r % 32;
            transpose_wave(inp(p, which ? 12 : 9) + (size_t)l * FH * 1024, 1024, kt * 64, nt * 32, (bf16_t*)(ws + (which ? WS_WDN2 : WS_WDN1)), FH, nt * 32, scr, lane);
        } else { r -= 2 * NT_DN; const int kt = r / 65, nt = r % 65;
            transpose_wave(inp(p, 13) + (size_t)l * 1024 * 2064, 2064, kt * 64, nt * 32, (bf16_t*)(ws + WS_WIN), 1024, nt * 32, scr, lane); }
      } }
    const float* wo = inp(p, 14) + (size_t)l * 1024 * 1024; bf16_t* WOUT = (bf16_t*)(ws + WS_WOUT);
    const float* CF = (const float*)(ws + WS_CF) + (size_t)l * 2 * 65536;
    for (int it = obx(); it < 320; it += ogd()) {
        const int ti = it * 512 + tid, j = ti & 1023, kk0 = (ti >> 10) * 8, region = kk0 >> 8, kl = kk0 & 255;
        float acc[8];
#pragma unroll
        for (int e = 0; e < 8; ++e) acc[e] = 0.f;
        if (region == 0) { const int g = kl >> 6, c0 = kl & 63; const float* pw = inp(p, 15) + (((size_t)l * 4 + g) * 64 + c0) * 64; const float* ps = inp(p, 16) + (size_t)l * 256 + g * 64;
#pragma unroll 8
            for (int t = 0; t < 64; ++t) { const float wv = wo[(size_t)(g * 64 + t) * 1024 + j] * ps[t];
#pragma unroll
                for (int e = 0; e < 8; ++e) acc[e] += pw[e * 64 + t] * wv; }
        } else if (region <= 3) { const float* Lm = (region == 3 ? inp(p, 22) + (size_t)l * 65536 : CF + (size_t)(region - 1) * 65536) + (size_t)kl * 256;
            const float* wr = wo + (size_t)(region == 3 ? 512 : 256) * 1024 + j; const float sc = region == 3 ? 1.f : 0.125f;
#pragma unroll 8
            for (int t = 0; t < 256; ++t) { const float wv = wr[(size_t)t * 1024];
#pragma unroll
                for (int e = 0; e < 8; ++e) acc[e] += Lm[e * 256 + t] * wv; }
#pragma unroll
            for (int e = 0; e < 8; ++e) acc[e] *= sc;
        } else {
#pragma unroll
            for (int e = 0; e < 8; ++e) acc[e] = wo[(size_t)(768 + kl + e) * 1024 + j];
        }
        uint4 o; o.x = pk2(acc[0], acc[1]); o.y = pk2(acc[2], acc[3]); o.z = pk2(acc[4], acc[5]); o.w = pk2(acc[6], acc[7]);
        *(uint4*)(WOUT + (size_t)j * YK + kk0) = o;
    }
    { const int lane = tid & 63, wv = __builtin_amdgcn_readfirstlane(tid >> 6); float* sh_s = sm + 17000; float* red = sm + 26300;
      const float* MODL = (const float*)(ws + WS_MOD) + (size_t)l * 3 * 9216; float* BIAS = (float*)(ws + WS_BIAS);
      __syncthreads();
      for (int i = tid; i < 9216; i += 512) { const int use = i / 3072, mr = (i / 1024) % 3, k = i & 1023; sh_s[i] = MODL[(size_t)mr * 9216 + (3 * use) * 1024 + k]; }
      __syncthreads();
      for (int it = obx(); it < 209; it += ogd()) {
          int use, n, N, drow; const float* W;
          if (it < 176) { const int mat = it / 44, n0 = (it - mat * 44) * 64; use = (mat >> 1) * 2; N = FH; n = n0 + lane; W = inp(p, mat == 0 ? 7 : mat == 1 ? 8 : mat == 2 ? 10 : 11) + (size_t)l * 1024 * FH;
              drow = 256 * (n >> 7) + 128 * (mat & 1) + (n & 127); }
          else { use = 1; N = 2064; n = (it - 176) * 64 + lane; W = inp(p, 13) + (size_t)l * 1024 * 2064; drow = n; }
          float a0 = 0.f, a1 = 0.f, a2 = 0.f;
          if (n < N) { const float* wp = W + (size_t)(wv * 128) * N + n; const float* s0 = sh_s + use * 3072 + wv * 128;
#pragma unroll 8
              for (int k = 0; k < 128; ++k) { const float x = wp[(size_t)k * N]; a0 += s0[k] * x; a1 += s0[1024 + k] * x; a2 += s0[2048 + k] * x; } }
          red[(wv * 3 + 0) * 64 + lane] = a0; red[(wv * 3 + 1) * 64 + lane] = a1; red[(wv * 3 + 2) * 64 + lane] = a2;
          __syncthreads();
          if (tid < 192 && n < N) { const int r = tid >> 6; float sacc = 0.f;
#pragma unroll
              for (int w8 = 0; w8 < 8; ++w8) sacc += red[(w8 * 3 + r) * 64 + lane];
              BIAS[((size_t)use * 3 + r) * 5632 + drow] = sacc; }
          __syncthreads();
      }
      float* RS1 = (float*)(ws + WS_RS + RS_STRIDE);
      for (int i = obx() * 512 + tid; i < MROWS; i += ogd() * 512) RS1[i] = 0.f; }
    if (l == 0) raw_rows(p);
}

struct EpiUp {
    static constexpr bool PERM = true, AFTER_DRAIN = false; bf16_t* H; const float* rs; const float* bias;
    DEVI void operator()(const f32x4 (&acc)[2][2][4][2], const Unit& u, int wr, int wc, int fr, int fq) const {
        const int row0 = u.pm * 256 + wr * 64 + fr, col0 = u.pn * 128 + wc * 32 + 8 * fq; const int mr = u.pm < 64 ? 0 : (u.pm < 128 ? 1 : 2);
        const float* bp = bias + (size_t)mr * 5632 + u.pn * 256 + wc * 32 + 8 * fq;
        const f32x4 bg0 = *(const f32x4*)bp, bg1 = *(const f32x4*)(bp + 4), bu0 = *(const f32x4*)(bp + 128), bu1 = *(const f32x4*)(bp + 132);
        float rsl[2][4];
#pragma unroll
        for (int ai = 0; ai < 2; ++ai)
#pragma unroll
            for (int m = 0; m < 4; ++m) rsl[ai][m] = rs[row0 + ai * 128 + m * 16];
#pragma unroll
        for (int ai = 0; ai < 2; ++ai)
#pragma unroll
            for (int m = 0; m < 4; ++m) { const int row = row0 + ai * 128 + m * 16; bf16_t* rowp = H + (size_t)row * FH + col0;
                const float rv = rsqrtf(rsl[ai][m] * (1.f / 1024.f) + EPS);
                const f32x4 g0 = acc[ai][0][m][0] * rv + bg0, g1 = acc[ai][0][m][1] * rv + bg1, u0 = acc[ai][1][m][0] * rv + bu0, u1 = acc[ai][1][m][1] * rv + bu1;
                u32x4 w; w.x = pk2(siluf(g0[0]) * u0[0], siluf(g0[1]) * u0[1]); w.y = pk2(siluf(g0[2]) * u0[2], siluf(g0[3]) * u0[3]);
                w.z = pk2(siluf(g1[0]) * u1[0], siluf(g1[1]) * u1[1]); w.w = pk2(siluf(g1[2]) * u1[2], siluf(g1[3]) * u1[3]);
                *(u32x4*)rowp = w; }
    }
};
struct EpiRes {
    static constexpr bool PERM = true, AFTER_DRAIN = false; float* outx; float* ctxr; const float* inx; const float* gate; bf16_t* nyraw; float* rsacc; const float* nw; const float* nscale; float mult; int feeds;
    DEVI void operator()(const f32x4 (&acc)[2][2][4][2], const Unit& u, int wr, int wc, int fr, int fq) const {
        const int row0 = u.pm * 256 + wr * 64 + fr, col0 = u.pn * 256 + wc * 32 + 8 * fq; const int mr = u.pm < 64 ? 0 : (u.pm < 128 ? 1 : 2);
        float* base = (u.pm < 128 ? outx + (size_t)row0 * D : ctxr + (size_t)(row0 - T) * D) + col0;
        const float* rbase = (u.pm < 128 ? inx + (size_t)row0 * D : ctxr + (size_t)(row0 - T) * D) + col0;
        f32x4 gv[2][2], cw[2][2];
#pragma unroll
        for (int bj = 0; bj < 2; ++bj)
#pragma unroll
            for (int n = 0; n < 2; ++n) { gv[bj][n] = *(const f32x4*)(gate + (size_t)mr * 9216 + col0 + bj * 128 + n * 4) * mult;
                cw[bj][n] = *(const f32x4*)(nw + col0 + bj * 128 + n * 4) * (*(const f32x4*)(nscale + (size_t)mr * 9216 + col0 + bj * 128 + n * 4) + 1.f); }
        f32x4 rq[2][2][2];
#pragma unroll
        for (int k0 = 0; k0 < 1; ++k0) { const float* rr = rbase + (size_t)((k0 >> 2) * 128 + (k0 & 3) * 16) * D;
#pragma unroll
            for (int bj = 0; bj < 2; ++bj) { rq[k0][bj][0] = *(const f32x4*)(rr + bj * 128); rq[k0][bj][1] = *(const f32x4*)(rr + bj * 128 + 4); } }
#pragma unroll
        for (int k = 0; k < 8; ++k) { const int ai = k >> 2, m = k & 3; float* rowp = base + (size_t)(ai * 128 + m * 16) * D; const int row = row0 + ai * 128 + m * 16; float ss = 0.f;
            if (k + 1 < 8) { const float* rr = rbase + (size_t)(((k + 1) >> 2) * 128 + ((k + 1) & 3) * 16) * D;
#pragma unroll
                for (int bj = 0; bj < 2; ++bj) { rq[(k + 1) & 1][bj][0] = *(const f32x4*)(rr + bj * 128); rq[(k + 1) & 1][bj][1] = *(const f32x4*)(rr + bj * 128 + 4); } }
#pragma unroll
            for (int bj = 0; bj < 2; ++bj) { f32x4* pp = (f32x4*)(rowp + bj * 128);
                const f32x4 n0 = rq[k & 1][bj][0] + gv[bj][0] * acc[ai][bj][m][0], n1 = rq[k & 1][bj][1] + gv[bj][1] * acc[ai][bj][m][1]; pp[0] = n0; pp[1] = n1;
                if (feeds) { const f32x4 y0 = n0 * cw[bj][0], y1 = n1 * cw[bj][1]; u32x4 o; o.x = pk2(y0[0], y0[1]); o.y = pk2(y0[2], y0[3]); o.z = pk2(y1[0], y1[1]); o.w = pk2(y1[2], y1[3]);
                    *(u32x4*)(nyraw + (size_t)row * 1024 + col0 + bj * 128) = o;
                    ss += n0[0] * n0[0] + n0[1] * n0[1] + n0[2] * n0[2] + n0[3] * n0[3] + n1[0] * n1[0] + n1[1] * n1[1] + n1[2] * n1[2] + n1[3] * n1[3]; } }
            if (feeds) { ss += __shfl_xor(ss, 16); ss += __shfl_xor(ss, 32); if (fq == 0) atomicAdd(rsacc + row, ss); } }
    }
};
struct EpiP {
    static constexpr bool PERM = true, AFTER_DRAIN = false; bf16_t* P; const float* rs; const float* bias;
    DEVI void operator()(const f32x4 (&acc)[2][2][4][2], const Unit& u, int wr, int wc, int fr, int fq) const {
        const int row0 = u.pm * 256 + wr * 64 + fr, col0 = u.pn * 256 + wc * 32 + 8 * fq; const int mr = u.pm < 64 ? 0 : (u.pm < 128 ? 1 : 2);
        const float* bp = bias + (size_t)mr * 5632 + col0;
        f32x4 b0[2], b1[2];
#pragma unroll
        for (int bj = 0; bj < 2; ++bj) { b0[bj] = *(const f32x4*)(bp + bj * 128); b1[bj] = *(const f32x4*)(bp + bj * 128 + 4); }
        float rsl[2][4];
#pragma unroll
        for (int ai = 0; ai < 2; ++ai)
#pragma unroll
            for (int m = 0; m < 4; ++m) rsl[ai][m] = rs[row0 + ai * 128 + m * 16];
#pragma unroll
        for (int ai = 0; ai < 2; ++ai)
#pragma unroll
            for (int m = 0; m < 4; ++m) { const int row = row0 + ai * 128 + m * 16; bf16_t* rowp = P + (size_t)row * PPITCH + col0;
                const float rv = rsqrtf(rsl[ai][m] * (1.f / 1024.f) + EPS);
#pragma unroll
                for (int bj = 0; bj < 2; ++bj) if (col0 + bj * 128 < 2064) { const f32x4 v0 = acc[ai][bj][m][0] * rv + b0[bj], v1 = acc[ai][bj][m][1] * rv + b1[bj];
                    u32x4 w; w.x = pk2(v0[0], v0[1]); w.y = pk2(v0[2], v0[3]); w.z = pk2(v1[0], v1[1]); w.w = pk2(v1[2], v1[3]);
                    *(u32x4*)(rowp + bj * 128) = w; } }
    }
};

DEVI f32x4 mini_dot(const bf16_t* arow, const bf16_t* wrow, int K) {
    f32x4 c0 = (f32x4){0.f, 0.f, 0.f, 0.f}, c1 = c0;
#pragma unroll 1
    for (int k = 0; k < K; k += 256) {
        pg8::bf16x8 a[8], w[8];
#pragma unroll
        for (int q = 0; q < 8; ++q) { a[q] = *(const pg8::bf16x8*)(arow + k + 32 * q); w[q] = *(const pg8::bf16x8*)(wrow + k + 32 * q); }
#pragma unroll
        for (int q = 0; q < 8; q += 2) { c0 = __builtin_amdgcn_mfma_f32_16x16x32_bf16(w[q], a[q], c0, 0, 0, 0); c1 = __builtin_amdgcn_mfma_f32_16x16x32_bf16(w[q + 1], a[q + 1], c1, 0, 0, 0); }
    }
    return c0 + c1;
}
DEVI void mini_dot2(const bf16_t* arow, const bf16_t* w0row, const bf16_t* w1row, int K, f32x4& r0, f32x4& r1) {
    f32x4 c0 = (f32x4){0.f, 0.f, 0.f, 0.f}, c1 = c0;
#pragma unroll 1
    for (int k = 0; k < K; k += 256) {
        pg8::bf16x8 a[8], w[8], v[8];
#pragma unroll
        for (int q = 0; q < 8; ++q) { a[q] = *(const pg8::bf16x8*)(arow + k + 32 * q); w[q] = *(const pg8::bf16x8*)(w0row + k + 32 * q); v[q] = *(const pg8::bf16x8*)(w1row + k + 32 * q); }
#pragma unroll
        for (int q = 0; q < 8; ++q) { c0 = __builtin_amdgcn_mfma_f32_16x16x32_bf16(w[q], a[q], c0, 0, 0, 0); c1 = __builtin_amdgcn_mfma_f32_16x16x32_bf16(v[q], a[q], c1, 0, 0, 0); }
    }
    r0 = c0; r1 = c1;
}
DEVI void mini_up(const Params& p, const bf16_t* Wup) { unsigned char* const ws = opq(p.ws);
    const int tid = otid(), lane = tid & 63, fr = lane & 15, fq = lane >> 4;
    const bf16_t* NYp = (const bf16_t*)(ws + WS_NY); bf16_t* H = (bf16_t*)(ws + WS_H);
    for (int id = obx() * 8 + (tid >> 6); id < 32 * 176; id += ogd() * 8) {
        const int rt = id / 176, h0 = (id - rt * 176) * 16, g0 = 256 * (h0 >> 7) + (h0 & 127);
        const bf16_t* arow = NYp + (size_t)(T + 16 * rt + fr) * 1024 + fq * 8;
        f32x4 g, u; mini_dot2(arow, Wup + (size_t)(g0 + fr) * 1024 + fq * 8, Wup + (size_t)(g0 + 128 + fr) * 1024 + fq * 8, 1024, g, u);
        uint2 o; o.x = pk2(siluf(g[0]) * u[0], siluf(g[1]) * u[1]); o.y = pk2(siluf(g[2]) * u[2], siluf(g[3]) * u[3]);
        *(uint2*)(H + (size_t)(T + 16 * rt + fr) * FH + h0 + 4 * fq) = o;
    }
}
DEVI void mini_res(const Params& p, const bf16_t* A, const bf16_t* W, int K, const float* gate, float mult, bf16_t* nyraw, float* rsacc, const float* nw, const float* nscale, const float* Rin, float* sm) { unsigned char* const ws = opq(p.ws);
    const int tid = otid(), lane = tid & 63, wv = tid >> 6, fr = lane & 15, fq = lane >> 4;
    float* R = (float*)(ws + WS_CTXR);
    const int nsteps = K >> 8, kw = (K >> 3) * wv;
    for (int id = obx(); id < 32 * 8; id += ogd()) {
        const int rt = id >> 3, cg = id & 7;
        const bf16_t* arow = A + (size_t)(T + 16 * rt + fr) * K + kw + fq * 8; const bf16_t* wrow = W + (size_t)(128 * cg + fr) * K + kw + fq * 8;
        f32x4 acc[8];
#pragma unroll
        for (int t = 0; t < 8; ++t) acc[t] = (f32x4){0.f, 0.f, 0.f, 0.f};
#pragma unroll 1
        for (int s0 = 0; s0 < nsteps; s0 += 4) {
            pg8::bf16x8 av[4], wf[4][8];
#pragma unroll
            for (int j = 0; j < 4; ++j) { const int o = ((s0 + j) < nsteps ? (s0 + j) : nsteps - 1) * 32; av[j] = *(const pg8::bf16x8*)(arow + o);
#pragma unroll
                for (int t = 0; t < 8; ++t) wf[j][t] = *(const pg8::bf16x8*)(wrow + (size_t)(16 * t) * K + o); }
#pragma unroll
            for (int j = 0; j < 4; ++j) if (s0 + j < nsteps) {
#pragma unroll
                for (int t = 0; t < 8; ++t) acc[t] = __builtin_amdgcn_mfma_f32_16x16x32_bf16(wf[j][t], av[j], acc[t], 0, 0, 0); }
        }
#pragma unroll
        for (int t = 0; t < 8; ++t) *(f32x4*)(sm + ((wv * 8 + t) * 64 + lane) * 4) = acc[t];
        __syncthreads();
        f32x4 tot = (f32x4){0.f, 0.f, 0.f, 0.f};
#pragma unroll
        for (int w8 = 0; w8 < 8; ++w8) tot += *(const f32x4*)(sm + ((w8 * 8 + wv) * 64 + lane) * 4);
        const int row = 16 * rt + fr, col = 128 * cg + 16 * wv + 4 * fq;
        const f32x4 gv = *(const f32x4*)(gate + 2 * 9216 + col) * mult;
        f32x4* pp = (f32x4*)(R + (size_t)row * D + col); const f32x4 nv = *(const f32x4*)(Rin + (size_t)row * D + col) + gv * tot; *pp = nv;
        if (nyraw) { const f32x4 y = nv * (*(const f32x4*)(nw + col) * (*(const f32x4*)(nscale + 2 * 9216 + col) + 1.f));
            uint2 o; o.x = pk2(y[0], y[1]); o.y = pk2(y[2], y[3]); *(uint2*)(nyraw + (size_t)(T + row) * 1024 + col) = o;
            float ss = nv[0] * nv[0] + nv[1] * nv[1] + nv[2] * nv[2] + nv[3] * nv[3]; ss += __shfl_xor(ss, 16); ss += __shfl_xor(ss, 32);
            if (fq == 0) atomicAdd(rsacc + T + row, ss); }
        __syncthreads();
    }
}
DEVI void mini_in(const Params& p) { unsigned char* const ws = opq(p.ws);
    const int tid = otid(), lane = tid & 63, fr = lane & 15, fq = lane >> 4;
    const bf16_t* NYp = (const bf16_t*)(ws + WS_NY); const bf16_t* W = (const bf16_t*)(ws + WS_WIN); bf16_t* P = (bf16_t*)(ws + WS_P);
    for (int id = obx() * 8 + (tid >> 6); id < 32 * 129 + 2048; id += ogd() * 8) {
        int row0, n0;
        if (id < 32 * 129) { const int rt = id / 129; row0 = T + 16 * rt; n0 = (id - rt * 129) * 16; } else { row0 = (id - 32 * 129) * 16; n0 = 2048; }
        const f32x4 acc = mini_dot(NYp + (size_t)(row0 + fr) * 1024 + fq * 8, W + (size_t)(n0 + fr) * 1024 + fq * 8, 1024);
        uint2 o; o.x = pk2(acc[0], acc[1]); o.y = pk2(acc[2], acc[3]);
        *(uint2*)(P + (size_t)(row0 + fr) * PPITCH + n0 + 4 * fq) = o;
    }
}

DEVI float dpp_xor1(float v) { return __int_as_float(__builtin_amdgcn_update_dpp(0, __float_as_int(v), 0xB1, 0xF, 0xF, true)); }
DEVI float dpp_xor2(float v) { return __int_as_float(__builtin_amdgcn_update_dpp(0, __float_as_int(v), 0x4E, 0xF, 0xF, true)); }
constexpr int CW_OFF = 28672;
struct G1Raw { uint4 v0[3], v1[3], v2[3]; unsigned ab; };
DEVI void g1_decode(int item, int tid, int& chain, int& ci, int& dir, int& h, int& seqbase, int& len, int& jj) {
    chain = item / NCH; ci = item - chain * NCH;
    const int b = chain >> 3; dir = (chain >> 2) & 1; h = chain & 3;
    int j, nc;
    if (ci < 4) { seqbase = T + b * 256; len = 256; j = ci; nc = 4; } else { seqbase = b * SEQ; len = SEQ; j = ci - 4; nc = 256; }
    jj = dir ? nc - 1 - j : j;
}
DEVI void g1_load(const Params& p, int item, G1Raw& raw) { unsigned char* const ws = opq(p.ws);
    const int tid = otid(); int chain, ci, dir, h, seqbase, len, jj; g1_decode(item, tid, chain, ci, dir, h, seqbase, len, jj);
    const bf16_t* P = (const bf16_t*)(ws + WS_P);
    const int r = tid >> 3, d8 = (tid & 7) * 8;
    const int pos = dir ? 64 * jj + 63 - r : 64 * jj + r, posL = pos > 0 ? pos - 1 : 0, posR = pos < len - 1 ? pos + 1 : len - 1;
    const bf16_t* pr = P + (size_t)(seqbase + pos) * PPITCH; const bf16_t* pl = P + (size_t)(seqbase + posL) * PPITCH; const bf16_t* pq = P + (size_t)(seqbase + posR) * PPITCH;
#pragma unroll
    for (int w3 = 0; w3 < 3; ++w3) { const int cb = 1024 + w3 * 256 + h * 64 + d8;
        raw.v1[w3] = *(const uint4*)(pr + cb); raw.v0[w3] = *(const uint4*)(pl + cb); raw.v2[w3] = *(const uint4*)(pq + cb); }
    const int hd = dir * 4 + h;
    raw.ab = (unsigned)pr[2048 + hd] | ((unsigned)pr[2056 + hd] << 16);
}
DEVI void g1_item(const Params& p, int l, int item, int next_item, G1Raw& raw, float* sm) { unsigned char* const ws = opq(p.ws);
    const int tid = otid(), lane = tid & 63, wv = tid >> 6;
    int chain, ci, dir, h, seqbase, len, jj; g1_decode(item, tid, chain, ci, dir, h, seqbase, len, jj);
    bf16_t* q_b = (bf16_t*)sm; bf16_t* k_b = q_b + 4608; bf16_t* kdT_b = q_b + 9216; bf16_t* aqk_b = q_b + 13824; bf16_t* XT_b = q_b + 18432;
    float* Mp = sm + 13824;
    float* X_s = sm + 18176;
    float* gc_s = sm + 26624; float* be_s = gc_s + 64; float* eg_s = gc_s + 128; float* kd_s = gc_s + 192; float* gt_s = gc_s + 256; float* misc = gc_s + 320;
    float kf[8];
    {
        const int r = tid >> 3, d8 = (tid & 7) * 8;
        const int pos = dir ? 64 * jj + 63 - r : 64 * jj + r;
        const bool hasL = pos > 0, hasR = pos < len - 1;
        const float* cw = sm + CW_OFF;
        float val[3][8];
#pragma unroll
        for (int w3 = 0; w3 < 3; ++w3) {
            const int cb = w3 * 256 + h * 64 + d8;
            const uint4 z = make_uint4(0u, 0u, 0u, 0u);
            const uint4 v1 = raw.v1[w3];
            const uint4 v0 = hasL ? raw.v0[w3] : z;
            const uint4 v2 = hasR ? raw.v2[w3] : z;
            float x0[8], x1[8], x2[8]; UNPACK8(v0, x0); UNPACK8(v1, x1); UNPACK8(v2, x2);
#pragma unroll
            for (int e = 0; e < 8; ++e) val[w3][e] = siluf(x0[e] * cw[cb + e] + x1[e] * cw[768 + cb + e] + x2[e] * cw[1536 + cb + e]);
        }
        const unsigned ab = raw.ab;
        if (next_item >= 0) g1_load(p, next_item, raw);
        float sq = 0.f, sk = 0.f;
#pragma unroll
        for (int e = 0; e < 8; ++e) { sq += val[0][e] * val[0][e]; sk += val[1][e] * val[1][e]; }
        sq += __shfl_xor(sq, 1); sq += __shfl_xor(sq, 2); sq += __shfl_xor(sq, 4);
        sk += __shfl_xor(sk, 1); sk += __shfl_xor(sk, 2); sk += __shfl_xor(sk, 4);
        const float qs = rsqrtf(sq + EPS) * 0.125f, ks = rsqrtf(sk + EPS);
        const int hd = dir * 4 + h;
        const float av = __uint_as_float(ab << 16), bv = __uint_as_float(ab & 0xFFFF0000u);
        const float beta = sigmf(bv);
        const float xa = av + inp(p, 25)[l * 8 + hd];
        const float sp = xa > 20.f ? xa : log1pf(__expf(xa));
        const float g = -__expf(inp(p, 24)[l * 8 + hd]) * sp;
#pragma unroll
        for (int e = 0; e < 8; ++e) kf[e] = val[1][e] * ks;
        uint4 o; o.x = pk2(val[0][0] * qs, val[0][1] * qs); o.y = pk2(val[0][2] * qs, val[0][3] * qs); o.z = pk2(val[0][4] * qs, val[0][5] * qs); o.w = pk2(val[0][6] * qs, val[0][7] * qs);
        *(uint4*)(q_b + r * 72 + d8) = o;
        o.x = pk2(kf[0], kf[1]); o.y = pk2(kf[2], kf[3]); o.z = pk2(kf[4], kf[5]); o.w = pk2(kf[6], kf[7]);
        *(uint4*)(k_b + r * 72 + d8) = o;
        *(float4*)(X_s + r * 132 + d8) = make_float4(val[2][0] * beta, val[2][1] * beta, val[2][2] * beta, val[2][3] * beta);
        *(float4*)(X_s + r * 132 + d8 + 4) = make_float4(val[2][4] * beta, val[2][5] * beta, val[2][6] * beta, val[2][7] * beta);
        if ((tid & 7) == 0) { gt_s[r] = g; be_s[r] = beta; }
    }
    __syncthreads();
    { float v = gt_s[lane];
#pragma unroll
        for (int o = 1; o < 64; o <<= 1) { const float t = __shfl_up(v, o); if (lane >= o) v += t; }
        const float gl = __shfl(v, 63); gc_s[lane] = v; eg_s[lane] = __expf(v); kd_s[lane] = __expf(gl - v); if (lane == 63) misc[0] = __expf(gl); }
    { const int r = tid >> 3, d8 = (tid & 7) * 8; const float f = be_s[r] * eg_s[r], kdr = kd_s[r];
        *(float4*)(X_s + r * 132 + 64 + d8) = make_float4(kf[0] * f, kf[1] * f, kf[2] * f, kf[3] * f);
        *(float4*)(X_s + r * 132 + 64 + d8 + 4) = make_float4(kf[4] * f, kf[5] * f, kf[6] * f, kf[7] * f);
#pragma unroll
        for (int e = 0; e < 8; ++e) kdT_b[(d8 + e) * 72 + ((((r >> 3) ^ (tid & 7)) << 3) | (r & 7))] = f2bf(kf[e] * kdr); }
    {
        const int isQ = wv >> 2, ti = wv & 3, fr = lane & 15, fq = lane >> 4;
        const bf16_t* Lb = isQ ? q_b : k_b;
        const pg8::bf16x8 a0 = *(const pg8::bf16x8*)(Lb + (16 * ti + fr) * 72 + fq * 8), a1 = *(const pg8::bf16x8*)(Lb + (16 * ti + fr) * 72 + fq * 8 + 32);
        for (int tj = 0; tj < 4; ++tj) {
            f32x4 acc = (f32x4){0.f, 0.f, 0.f, 0.f};
            if (tj <= ti) {
                const pg8::bf16x8 b0 = *(const pg8::bf16x8*)(k_b + (16 * tj + fr) * 72 + fq * 8), b1 = *(const pg8::bf16x8*)(k_b + (16 * tj + fr) * 72 + fq * 8 + 32);
                acc = __builtin_amdgcn_mfma_f32_16x16x32_bf16(a0, b0, acc, 0, 0, 0);
                acc = __builtin_amdgcn_mfma_f32_16x16x32_bf16(a1, b1, acc, 0, 0, 0);
            }
            const int jn = 16 * tj + fr; const float gj = gc_s[jn];
#pragma unroll
            for (int rg = 0; rg < 4; ++rg) { const int i = 16 * ti + fq * 4 + rg;
                const float dec = i >= jn ? __expf(gc_s[i] - gj) : 0.f;
                if (!isQ) { if (tj <= ti) Mp[i * 68 + (jn & 3) * 16 + (jn >> 2)] = (i > jn) ? be_s[i] * acc[rg] * dec : 0.f; }
                else aqk_b[i * 72 + jn] = (i >= jn) ? f2bf(acc[rg] * dec) : (bf16_t)0; }
        }
    }
    float* Td = gc_s + 384;
    if (wv < 4) {
        const int I = wv, cq = lane >> 2, pp = lane & 3;
        float xr[4] = {0.f, 0.f, 0.f, 0.f}, mb[16][4];
#pragma unroll
        for (int r = 0; r < 16; ++r) { const float4 m4 = *(const float4*)(Mp + (16 * I + r) * 68 + pp * 16 + 4 * I); mb[r][0] = m4.x; mb[r][1] = m4.y; mb[r][2] = m4.z; mb[r][3] = m4.w; }
#pragma unroll
        for (int r = 0; r < 16; ++r) { float part = 0.f;
#pragma unroll
            for (int q = 0; q < (r + 3) / 4; ++q) part += mb[r][q] * xr[q];
            part += dpp_xor1(part); part += dpp_xor2(part);
            const float ti = (r == cq ? 1.f : 0.f) - part;
            if (pp == (r & 3)) xr[r >> 2] = ti; }
#pragma unroll
        for (int q = 0; q < 4; ++q) Td[I * 256 + (4 * q + pp) * 16 + cq] = xr[q];
    }
    __syncthreads();
    {
        const int fr = lane & 15, fq = lane >> 4, c = 16 * wv + fr;
        f32x4 R[4];
#pragma unroll
        for (int I = 0; I < 4; ++I)
#pragma unroll
            for (int rg = 0; rg < 4; ++rg) R[I][rg] = X_s[(16 * I + 4 * fq + rg) * 132 + c];
#pragma unroll
        for (int I = 0; I < 4; ++I) {
            f32x4 x = (f32x4){0.f, 0.f, 0.f, 0.f};
#pragma unroll
            for (int kk = 0; kk < 4; ++kk) x = __builtin_amdgcn_mfma_f32_16x16x4f32(Td[I * 256 + fr * 16 + 4 * fq + kk], R[I][kk], x, 0, 0, 0);
#pragma unroll
            for (int I2 = I + 1; I2 < 4; ++I2)
#pragma unroll
                for (int kk = 0; kk < 4; ++kk) R[I2] = __builtin_amdgcn_mfma_f32_16x16x4f32(-Mp[(16 * I2 + fr) * 68 + kk * 16 + 4 * I + fq], x[kk], R[I2], 0, 0, 0);
            uint2 o; o.x = pk2(x[0], x[1]); o.y = pk2(x[2], x[3]);
            *(uint2*)(XT_b + c * 72 + 16 * I + 4 * fq) = o;
        }
    }
    __syncthreads();
    {
        const int fr = lane & 15, fq = lane >> 4, c = 16 * wv + fr;
        const pg8::bf16x8 b0 = *(const pg8::bf16x8*)(XT_b + c * 72 + fq * 8), b1 = *(const pg8::bf16x8*)(XT_b + c * 72 + fq * 8 + 32);
        const float egl = misc[0];
        float* rec = (float*)(ws + WS_GD) + (size_t)(chain * NCH + ci) * GD_REC_F;
        bf16_t* Qp = (bf16_t*)(rec + 8192); bf16_t* Op = Qp + 4096;
#pragma unroll
        for (int rt = 0; rt < 4; ++rt) {
            const int kg = (2 * rt + (fr >> 3)) & 7;
            const pg8::bf16x8 k0 = *(const pg8::bf16x8*)(kdT_b + (16 * rt + fr) * 72 + ((fq ^ kg) << 3)), k1 = *(const pg8::bf16x8*)(kdT_b + (16 * rt + fr) * 72 + (((fq + 4) ^ kg) << 3));
            const pg8::bf16x8 q0 = *(const pg8::bf16x8*)(aqk_b + (16 * rt + fr) * 72 + fq * 8), q1 = *(const pg8::bf16x8*)(aqk_b + (16 * rt + fr) * 72 + fq * 8 + 32);
            f32x4 a1 = (f32x4){0.f, 0.f, 0.f, 0.f}, a2 = (f32x4){0.f, 0.f, 0.f, 0.f};
            a1 = __builtin_amdgcn_mfma_f32_16x16x32_bf16(k0, b0, a1, 0, 0, 0); a1 = __builtin_amdgcn_mfma_f32_16x16x32_bf16(k1, b1, a1, 0, 0, 0);
            a2 = __builtin_amdgcn_mfma_f32_16x16x32_bf16(q0, b0, a2, 0, 0, 0); a2 = __builtin_amdgcn_mfma_f32_16x16x32_bf16(q1, b1, a2, 0, 0, 0);
#pragma unroll
            for (int rg = 0; rg < 4; ++rg) { const int d1 = 16 * rt + fq * 4 + rg;
                if (wv < 4) { rec[4096 + (((c >> 4) * 4 + (d1 >> 4)) * 64 + ((d1 >> 2) & 3) * 16 + (c & 15)) * 4 + (d1 & 3)] = a1[rg]; Op[d1 * 64 + c] = f2bf(a2[rg]); }
                else { const int cc = c - 64; rec[(((d1 >> 4) * 4 + (cc >> 4)) * 64 + (cc & 3) * 16 + (d1 & 15)) * 4 + ((cc >> 2) & 3)] = (d1 == cc ? egl : 0.f) - a1[rg]; Qp[d1 * 64 + cc] = f2bf(bf2f(q_b[d1 * 72 + cc]) * eg_s[d1] - a2[rg]); } }
        }
    }
    __syncthreads();
}

template <int LOGN, int LOGCH>
DEVI void fft_lds(float2* X, const float2* tw) {
    const int tid = otid(); constexpr int CH = 1 << LOGCH;
#pragma unroll 1
    for (int s = 1; s <= LOGN; ++s) {
        const int half = 1 << (s - 1);
#pragma unroll
        for (int i = 0; i < 8; ++i) {
            const int bi = tid + 512 * i, ch = bi & (CH - 1), bf = bi >> LOGCH;
            const int jx = bf & (half - 1), grp = bf >> (s - 1);
            const int i0 = (grp << s) + jx, i1 = i0 + half;
            const float2 w = tw[jx << (LOGN - s)];
            const float2 a = X[i0 * CH + ch], bq = X[i1 * CH + ch];
            const float2 t = make_float2(w.x * bq.x - w.y * bq.y, w.x * bq.y + w.y * bq.x);
            X[i0 * CH + ch] = make_float2(a.x + t.x, a.y + t.y); X[i1 * CH + ch] = make_float2(a.x - t.x, a.y - t.y);
        }
        __syncthreads();
    }
}
DEVI void fft128_lds(float2* X, const float2* tw) { fft_lds<7, 6>(X, tw); }
DEVI void trig_tables(float* sm) {
    const int tid = otid();
    if (tid < 64) { float s, c; sincospif((float)tid * (1.f / 64.f), &s, &c); ((float2*)(sm + TAB_OFF))[tid] = make_float2(c, -s); }
    if (tid < 128) { float s, c; sincospif((float)tid * (1.f / 128.f), &s, &c); ((float2*)(sm + TAB_OFF + 128))[tid] = make_float2(c, -s); }
    __syncthreads();
}
DEVI void fft1_item(const Params& p, int item, float* sm) { unsigned char* const ws = opq(p.ws);
    const int tid = otid(); const int cb = item & 3, bb = (item >> 2) & 127, b = item >> 9;
    const bf16_t* P = (const bf16_t*)(ws + WS_P); float2* X = (float2*)sm; const float2* tw = (const float2*)(sm + TAB_OFF);
#pragma unroll
    for (int i = 0; i < 2; ++i) { const int ti = tid + 512 * i, a = ti >> 3, c8 = ti & 7;
        const uint4 v = *(const uint4*)(P + (size_t)(b * SEQ + 128 * a + bb) * PPITCH + 256 + cb * 64 + c8 * 8);
        float f[8]; UNPACK8(v, f); const int ra = (int)(__brev((unsigned)a) >> 25);
#pragma unroll
        for (int e = 0; e < 8; ++e) X[ra * 64 + c8 * 8 + e] = make_float2(f[e], 0.f); }
    __syncthreads();
    fft128_lds(X, tw);
    float2* FS = (float2*)(ws + WS_FS);
    float s, co, ss, cs; sincospif((float)(bb * (tid >> 6)) * (-2.f / 16384.f), &s, &co); sincospif((float)(bb * 8) * (-2.f / 16384.f), &ss, &cs);
#pragma unroll 4
    for (int i = 0; i < 16; ++i) { const int ti = tid + 512 * i, ch = ti & 63, c = ti >> 6;
        const float2 v = X[c * 64 + ch];
        FS[((size_t)(b * 128 + c) * 128 + bb) * 256 + cb * 64 + ch] = make_float2(v.x * co - v.y * s, v.x * s + v.y * co);
        const float nc = co * cs - s * ss, ns = co * ss + s * cs; co = nc; s = ns; }
    __syncthreads();
}
DEVI void fft2_item(const Params& p, int item, float* sm) { unsigned char* const ws = opq(p.ws);
    const int tid = otid(); const int cb = item & 3, c = (item >> 2) & 127, b = item >> 9;
    float2* X = (float2*)sm; const float2* tw = (const float2*)(sm + TAB_OFF);
    const float2* FS = (const float2*)(ws + WS_FS) + (size_t)(b * 128 + c) * 128 * 256 + cb * 64;
#pragma unroll 4
    for (int i = 0; i < 16; ++i) { const int ti = tid + 512 * i, ch = ti & 63, bb = ti >> 6;
        X[(int)(__brev((unsigned)bb) >> 25) * 64 + ch] = FS[(size_t)bb * 256 + ch]; }
    __syncthreads();
    fft128_lds(X, tw);
    bf16_t* Y = (bf16_t*)(ws + WS_NY);
#pragma unroll
    for (int i = 0; i < 2; ++i) { const int ti = tid + 512 * i, d = ti >> 3, c8 = ti & 7;
        float re[8], im[8];
#pragma unroll
        for (int e = 0; e < 8; ++e) { const float2 v = X[d * 64 + c8 * 8 + e]; re[e] = v.x * (1.f / 128.f); im[e] = v.y * (1.f / 128.f); }
        bf16_t* yr = Y + (size_t)(b * SEQ + c + 128 * d) * YK + 256 + cb * 64 + c8 * 8;
        uint4 o; o.x = pk2(re[0], re[1]); o.y = pk2(re[2], re[3]); o.z = pk2(re[4], re[5]); o.w = pk2(re[6], re[7]); *(uint4*)yr = o;
        o.x = pk2(im[0], im[1]); o.y = pk2(im[2], im[3]); o.z = pk2(im[4], im[5]); o.w = pk2(im[6], im[7]); *(uint4*)(yr + 256) = o; }
    __syncthreads();
}
DEVI void ctxfft_item(const Params& p, int item, float* sm) { unsigned char* const ws = opq(p.ws);
    const int tid = otid(); const int cb = item & 7, b = item >> 3;
    const bf16_t* P = (const bf16_t*)(ws + WS_P); float2* X = (float2*)sm; const float2* tw = (const float2*)(sm + TAB_OFF + 128);
#pragma unroll
    for (int i = 0; i < 2; ++i) { const int ti = tid + 512 * i, n = ti >> 2, c8 = ti & 3;
        const uint4 v = *(const uint4*)(P + (size_t)(T + b * 256 + n) * PPITCH + 256 + cb * 32 + c8 * 8);
        float f[8]; UNPACK8(v, f); const int rn = (int)(__brev((unsigned)n) >> 24);
#pragma unroll
        for (int e = 0; e < 8; ++e) X[rn * 32 + c8 * 8 + e] = make_float2(f[e], 0.f); }
    __syncthreads();
    fft_lds<8, 5>(X, tw);
    bf16_t* Y = (bf16_t*)(ws + WS_NY);
#pragma unroll
    for (int i = 0; i < 2; ++i) { const int ti = tid + 512 * i, k = ti >> 2, c8 = ti & 3;
        float re[8], im[8];
#pragma unroll
        for (int e = 0; e < 8; ++e) { const float2 v = X[k * 32 + c8 * 8 + e]; re[e] = v.x * (1.f / 16.f); im[e] = v.y * (1.f / 16.f); }
        bf16_t* yr = Y + (size_t)(T + b * 256 + k) * YK + 256 + cb * 32 + c8 * 8;
        uint4 o; o.x = pk2(re[0], re[1]); o.y = pk2(re[2], re[3]); o.z = pk2(re[4], re[5]); o.w = pk2(re[6], re[7]); *(uint4*)yr = o;
        o.x = pk2(im[0], im[1]); o.y = pk2(im[2], im[3]); o.z = pk2(im[4], im[5]); o.w = pk2(im[6], im[7]); *(uint4*)(yr + 256) = o; }
    __syncthreads();
}
DEVI void conv_item(const Params& p, int l, int item, float* sm) { unsigned char* const ws = opq(p.ws);
    const int tid = otid(), lane = tid & 63, wv = tid >> 6;
    int base, len, tile;
    if (item < 1024) { base = (item >> 9) * SEQ; len = SEQ; tile = item & 511; } else { const int cj = item - 1024; base = T + (cj >> 3) * 256; len = 256; tile = cj & 7; }
    const int t0 = tile * 32;
    const bf16_t* P = (const bf16_t*)(ws + WS_P);
    float* glu = sm;
    float* hb = sm + 62 * 256;
    for (int ti = tid; ti < 62 * 32; ti += 512) { const int pp = ti >> 5, c8 = ti & 31, pos = t0 - 15 + pp;
        float o[8];
        if (pos >= 0 && pos < len) { const bf16_t* pr = P + (size_t)(base + pos) * PPITCH + 512 + c8 * 8;
            const uint4 va = *(const uint4*)pr, vb = *(const uint4*)(pr + 256); float fa[8], fb[8]; UNPACK8(va, fa); UNPACK8(vb, fb);
#pragma unroll
            for (int e = 0; e < 8; ++e) o[e] = fa[e] * sigmf(fb[e]);
        } else {
#pragma unroll
            for (int e = 0; e < 8; ++e) o[e] = 0.f; }
        *(float4*)(glu + pp * 256 + c8 * 8) = make_float4(o[0], o[1], o[2], o[3]); *(float4*)(glu + pp * 256 + c8 * 8 + 4) = make_float4(o[4], o[5], o[6], o[7]); }
    __syncthreads();
    { const int ch = tid & 255, half = tid >> 8; const float* w = inp(p, 18) + (size_t)l * 31 * 256 + ch; const float bias = inp(p, 19)[l * 256 + ch];
        float wr[31];
#pragma unroll
        for (int jx = 0; jx < 31; ++jx) wr[jx] = w[jx * 256];
        float win[46];
#pragma unroll
        for (int jx = 0; jx < 46; ++jx) win[jx] = glu[(half * 16 + jx) * 256 + ch];
#pragma unroll
        for (int pi = 0; pi < 16; ++pi) { float h = bias;
#pragma unroll
            for (int jx = 0; jx < 31; ++jx) h += win[pi + jx] * wr[jx];
            hb[(half * 16 + pi) * 256 + ch] = h; } }
    __syncthreads();
    { const float4 g4 = *(const float4*)(inp(p, 20) + l * 256 + lane * 4), b4 = *(const float4*)(inp(p, 21) + l * 256 + lane * 4);
        bf16_t* Y = (bf16_t*)(ws + WS_NY);
#pragma unroll
        for (int qi = 0; qi < 4; ++qi) { const int q = wv * 4 + qi; const float4 h4 = *(const float4*)(hb + q * 256 + lane * 4);
            const float mu = wave_sum(h4.x + h4.y + h4.z + h4.w) * (1.f / 256.f);
            const float dx = h4.x - mu, dy = h4.y - mu, dz = h4.z - mu, dw = h4.w - mu;
            const float var = wave_sum(dx * dx + dy * dy + dz * dz + dw * dw) * (1.f / 256.f); const float rs = rsqrtf(var + EPS);
            uint2 o; o.x = pk2(siluf(dx * rs * g4.x + b4.x), siluf(dy * rs * g4.y + b4.y)); o.y = pk2(siluf(dz * rs * g4.z + b4.z), siluf(dw * rs * g4.w + b4.w));
            *(uint2*)(Y + (size_t)(base + t0 + q) * YK + 768 + lane * 4) = o; } }
    __syncthreads();
}
DEVI void poolx_item(const Params& p, int item, float* sm) { unsigned char* const ws = opq(p.ws);
    const int tid = otid(); const int g = item & 3, r0 = ((item >> 2) & 31) * 8, b = item >> 7, w = 2 << g, hw = w >> 1;
    const int c = tid >> 3, c8 = tid & 7, ch0 = g * 64 + c8 * 8;
    const bf16_t* P = (const bf16_t*)(ws + WS_P) + (size_t)b * SEQ * PPITCH + (size_t)c * PPITCH + ch0;
    bf16_t* Y = (bf16_t*)(ws + WS_NY) + (size_t)b * SEQ * YK + (size_t)c * YK + ch0;
    float* Vs = sm;
#define ADD8(A, B, v, sgn) do { (A).x += (sgn) * __uint_as_float((v).x << 16); (A).y += (sgn) * __uint_as_float((v).x & 0xFFFF0000u); (A).z += (sgn) * __uint_as_float((v).y << 16); (A).w += (sgn) * __uint_as_float((v).y & 0xFFFF0000u); \
        (B).x += (sgn) * __uint_as_float((v).z << 16); (B).y += (sgn) * __uint_as_float((v).z & 0xFFFF0000u); (B).z += (sgn) * __uint_as_float((v).w << 16); (B).w += (sgn) * __uint_as_float((v).w & 0xFFFF0000u); } while (0)
    float4 V0 = make_float4(0.f, 0.f, 0.f, 0.f), V1 = V0;
    { const int lo = max(r0 - hw, 0), hi = min(r0 + w - hw, 256);
#pragma unroll
      for (int rr = 0; rr < 16; ++rr) { const int r = lo + rr; if (r < hi) { const uint4 v = *(const uint4*)(P + (size_t)r * 64 * PPITCH); ADD8(V0, V1, v, 1.f); } } }
    const int c0 = max(c - hw, 0), c1 = min(c + w - hw, 64);
#pragma unroll 1
    for (int i = 0; i < 8; ++i) { const int r = r0 + i, radd = r + w - hw, rsub = r - hw;
        *(float4*)(Vs + c * 64 + c8 * 8) = V0; *(float4*)(Vs + c * 64 + c8 * 8 + 4) = V1;
        const uint4 z = make_uint4(0u, 0u, 0u, 0u);
        uint4 va = *(const uint4*)(P + (size_t)min(radd, 255) * 64 * PPITCH), vs = *(const uint4*)(P + (size_t)max(rsub, 0) * 64 * PPITCH); const uint4 uv = *(const uint4*)(P + (size_t)r * 64 * PPITCH);
        if (radd >= 256) va = z; if (rsub < 0) vs = z;
        __syncthreads();
        float4 s0 = make_float4(0.f, 0.f, 0.f, 0.f), s1 = s0;
        for (int cc = c0; cc < c1; ++cc) { const float4 x = *(const float4*)(Vs + cc * 64 + c8 * 8), y = *(const float4*)(Vs + cc * 64 + c8 * 8 + 4);
            s0.x += x.x; s0.y += x.y; s0.z += x.z; s0.w += x.w; s1.x += y.x; s1.y += y.y; s1.z += y.z; s1.w += y.w; }
        const float inv = 1.f / (float)((min(radd, 256) - max(rsub, 0)) * (c1 - c0));
        float4 u0 = make_float4(0.f, 0.f, 0.f, 0.f), u1 = u0; ADD8(u0, u1, uv, 1.f);
        uint4 o; o.x = pk2(s0.x * inv - u0.x, s0.y * inv - u0.y); o.y = pk2(s0.z * inv - u0.z, s0.w * inv - u0.w); o.z = pk2(s1.x * inv - u1.x, s1.y * inv - u1.y); o.w = pk2(s1.z * inv - u1.z, s1.w * inv - u1.w);
        *(uint4*)(Y + (size_t)r * 64 * YK) = o;
        ADD8(V0, V1, va, 1.f); ADD8(V0, V1, vs, -1.f);
        __syncthreads();
    }
#undef ADD8
}
DEVI void poolc_item(const Params& p, int item) { unsigned char* const ws = opq(p.ws);
    const int tid = otid(); const bf16_t* P = (const bf16_t*)(ws + WS_P); bf16_t* Y = (bf16_t*)(ws + WS_NY);
    const int b = item >> 4, c8 = tid & 31, n = (item & 15) * 16 + (tid >> 5), w = 2 << (c8 >> 3);
    const int lo = max(n - w / 2, 0), hi = min(n + w - w / 2, 256);
    float s[8];
#pragma unroll
    for (int e = 0; e < 8; ++e) s[e] = 0.f;
#pragma unroll
    for (int rr = 0; rr < 16; ++rr) { const int r = lo + rr; if (r < hi) { const uint4 v = *(const uint4*)(P + (size_t)(T + b * 256 + r) * PPITCH + c8 * 8); float f[8]; UNPACK8(v, f);
#pragma unroll
        for (int e = 0; e < 8; ++e) s[e] += f[e]; } }
    const float inv = 1.f / (float)(hi - lo); const size_t row = (size_t)(T + b * 256 + n);
    const uint4 uv = *(const uint4*)(P + row * PPITCH + c8 * 8); float u[8]; UNPACK8(uv, u);
    uint4 o; o.x = pk2(s[0] * inv - u[0], s[1] * inv - u[1]); o.y = pk2(s[2] * inv - u[2], s[3] * inv - u[3]); o.z = pk2(s[4] * inv - u[4], s[5] * inv - u[5]); o.w = pk2(s[6] * inv - u[6], s[7] * inv - u[7]);
    *(uint4*)(Y + row * YK + c8 * 8) = o;
}
#ifndef M2_CONV
#define M2_CONV 0
#define M2_POOL 1
#endif
DEVI void phase_m1(const Params& p, int l, float* sm) {
    trig_tables(sm);
    constexpr int N_G1 = 16 * NCH, N_F1 = 1024, N_CV = 1040, N_PX = 256, N_CF = 16, N_PC = 32;
    const int G = ogd(), bx = obx();
    { const float* cwg = inp(p, 23) + (size_t)l * 3 * 768; for (int i = otid(); i < 2304; i += 512) sm[CW_OFF + i] = cwg[i]; }
    __syncthreads();
    { G1Raw raw; int it = bx; if (it < N_G1) g1_load(p, it, raw);
      for (; it < N_G1; it += G) g1_item(p, l, it, it + G < N_G1 ? it + G : -1, raw, sm); }
    for (int it = (bx + 192) % G; it < N_F1; it += G) fft1_item(p, it, sm);
    if (!M2_CONV) for (int it = (bx + 176) % G; it < N_CV; it += G) conv_item(p, l, it, sm);
    if (!M2_POOL) { for (int it = bx; it < N_PX; it += G) poolx_item(p, it, sm);
        for (int it = (bx + 128) % G; it < N_CF; it += G) ctxfft_item(p, it, sm);
        for (int it = (bx + 96) % G; it < N_PC; it += G) poolc_item(p, it); }
}

DEVI void scan_block(const Params& p, int sb, float* sm) { unsigned char* const ws = opq(p.ws);
    const int tid = otid(), lane = tid & 63, wv = tid >> 6, chain = sb >> 2, slice = sb & 3;
    const int rt = wv & 3, fr = lane & 15, fq = lane >> 4; const bool act = wv < 4;
    float* Sl = sm;
    float* base = (float*)(ws + WS_GD) + (size_t)chain * NCH * GD_REC_F;
    const int aoff = (rt * 4 * 64 + lane) * 4, boff = 4096 + ((slice * 4 + rt) * 64 + lane) * 4;
    float zz = 0.f; asm volatile("" : "+v"(zz));
    f32x4 sreg = (f32x4){zz, zz, zz, zz};
    if (act) {
#pragma unroll
        for (int rg = 0; rg < 4; ++rg) Sl[(16 * rt + 4 * fq + rg) * 16 + fr] = zz; }
    f32x4 a_0[4], a_1[4], a_2[4], a_3[4], a_4[4], a_5[4], a_6[4], a_7[4]; f32x4 b_0, b_1, b_2, b_3, b_4, b_5, b_6, b_7;
    b_0 = b_1 = b_2 = b_3 = b_4 = b_5 = b_6 = b_7 = sreg;
#pragma unroll
    for (int q = 0; q < 4; ++q) a_0[q] = a_1[q] = a_2[q] = a_3[q] = a_4[q] = a_5[q] = a_6[q] = a_7[q] = sreg;
#define SC_LD(st, idx) do { const float* ra_ = base + (size_t)((idx) < NCH ? (idx) : NCH - 1) * GD_REC_F; b_##st = *(const f32x4*)(ra_ + boff); \
        _Pragma("unroll") for (int q = 0; q < 4; ++q) a_##st[q] = *(const f32x4*)(ra_ + aoff + q * 256); } while (0)
#define SC_STEP(st, sn, idx) do { \
        f32x4 c0_ = b_##st, c1_ = (f32x4){0.f, 0.f, 0.f, 0.f}; \
        if (act) { \
            const float* Sc_ = Sl + ((idx) & 1) * 1024; \
            asm volatile("" :: "v"(c0_[0]), "v"(c0_[3]) : "memory"); \
            *(f32x4*)(base + (size_t)(idx) * GD_REC_F + boff) = sreg; \
            _Pragma("unroll") for (int kk = 0; kk < 16; kk += 2) { \
                const float s0_ = Sc_[(4 * kk + fq) * 16 + fr], s1_ = Sc_[(4 * kk + 4 + fq) * 16 + fr]; \
                c0_ = __builtin_amdgcn_mfma_f32_16x16x4f32(a_##st[kk >> 2][kk & 3], s0_, c0_, 0, 0, 0); \
                c1_ = __builtin_amdgcn_mfma_f32_16x16x4f32(a_##st[(kk + 1) >> 2][(kk + 1) & 3], s1_, c1_, 0, 0, 0); } \
        } \
        SC_LD(sn, (idx) + 7); \
        if (act) { float* Sn_ = Sl + (((idx) + 1) & 1) * 1024; sreg = c0_ + c1_; \
            _Pragma("unroll") for (int rg = 0; rg < 4; ++rg) Sn_[(16 * rt + 4 * fq + rg) * 16 + fr] = sreg[rg]; } \
        __syncthreads(); } while (0)
    SC_LD(0, 0); SC_LD(1, 1); SC_LD(2, 2); SC_LD(3, 3); SC_LD(4, 4); SC_LD(5, 5); SC_LD(6, 6);
    __syncthreads();
#pragma unroll 1
    for (int i = 0; i < 256; i += 8) { SC_STEP(0, 7, i); SC_STEP(1, 0, i + 1); SC_STEP(2, 1, i + 2); SC_STEP(3, 2, i + 3); SC_STEP(4, 3, i + 4); SC_STEP(5, 4, i + 5); SC_STEP(6, 5, i + 6); SC_STEP(7, 6, i + 7); }
    SC_STEP(0, 7, 256); SC_STEP(1, 0, 257); SC_STEP(2, 1, 258); SC_STEP(3, 2, 259);
    static_assert(NCH == 260, "scan tail written for 260 chunks");
#undef SC_LD
#undef SC_STEP
    __syncthreads();
}
DEVI void phase_m2(const Params& p, int l, float* sm) {
    trig_tables(sm);
    if (obx() < 64) { scan_block(p, obx(), sm); return; }
    constexpr int N_F2 = 1024, N_CV = 1040, N_PX = 256, N_CF = 16, N_PC = 32;
    const int G = ogd() - 64, bx = obx() - 64;
    for (int it = bx; it < N_F2; it += G) fft2_item(p, it, sm);
    const bool lastl = (l == NLAYER - 1);
    if (M2_CONV) for (int it = (bx + 64) % G; it < (lastl ? 1024 : N_CV); it += G) conv_item(p, l, it, sm);
    if (M2_POOL) { for (int it = (bx + 32) % G; it < N_PX; it += G) poolx_item(p, it, sm);
        if (!lastl) { for (int it = bx; it < N_CF; it += G) ctxfft_item(p, it, sm);
            for (int it = (bx + 96) % G; it < N_PC; it += G) poolc_item(p, it); } }
}

DEVI void g3_item(const Params& p, int l, int item, float* sm) { unsigned char* const ws = opq(p.ws);
    const int tid = otid(); const int b = item / (4 * NCH), rem = item - b * 4 * NCH, h = rem / NCH, jc = rem - h * NCH;
    int i_f, i_b, rowbase;
    if (jc < 4) { i_f = jc; i_b = 3 - jc; rowbase = T + b * 256 + 64 * jc; } else { const int jx = jc - 4; i_f = 4 + jx; i_b = 4 + 255 - jx; rowbase = b * SEQ + 64 * jx; }
    const float* recf = (const float*)(ws + WS_GD) + (size_t)(((b * 2 + 0) * 4 + h) * NCH + i_f) * GD_REC_F;
    const float* recb = (const float*)(ws + WS_GD) + (size_t)(((b * 2 + 1) * 4 + h) * NCH + i_b) * GD_REC_F;
    float* Qf = sm; float* Sf = sm + 4352; float* Qb = sm + 8448; float* Sb = sm + 12800;
    const int rt = tid >> 5, ct = tid & 31, r0 = 4 * rt, c0 = 2 * ct;
    const bf16_t* Of = (const bf16_t*)(recf + 8192) + 4096; const bf16_t* Ob = (const bf16_t*)(recb + 8192) + 4096;
    const bf16_t* P = (const bf16_t*)(ws + WS_P); bf16_t* Y = (bf16_t*)(ws + WS_NY);
    unsigned vf[4], vb[4], zv[4];
#pragma unroll
    for (int x = 0; x < 4; ++x) { vf[x] = *(const unsigned*)(Of + (r0 + x) * 64 + c0); vb[x] = *(const unsigned*)(Ob + (63 - r0 - x) * 64 + c0);
        zv[x] = *(const unsigned*)(P + (size_t)(rowbase + r0 + x) * PPITCH + 1792 + h * 64 + c0); }
    for (int i = tid; i < 1024; i += 512) { const int r = i >> 4, c4 = (i & 15) * 4;
        { const float4 sf = *(const float4*)(recf + 4096 + i * 4), sb = *(const float4*)(recb + 4096 + i * 4);
          const int ln = i & 63, d0 = 16 * ((i >> 6) & 3) + 4 * (ln >> 4), dv = 16 * (i >> 8) + (ln & 15);
          Sf[(d0 + 0) * 64 + dv] = sf.x; Sf[(d0 + 1) * 64 + dv] = sf.y; Sf[(d0 + 2) * 64 + dv] = sf.z; Sf[(d0 + 3) * 64 + dv] = sf.w;
          Sb[(d0 + 0) * 64 + dv] = sb.x; Sb[(d0 + 1) * 64 + dv] = sb.y; Sb[(d0 + 2) * 64 + dv] = sb.z; Sb[(d0 + 3) * 64 + dv] = sb.w; }
        const uint2 qf = *(const uint2*)((const bf16_t*)(recf + 8192) + r * 64 + c4), qb = *(const uint2*)((const bf16_t*)(recb + 8192) + r * 64 + c4);
        *(float4*)(Qf + r * 68 + c4) = make_float4(__uint_as_float(qf.x << 16), __uint_as_float(qf.x & 0xFFFF0000u), __uint_as_float(qf.y << 16), __uint_as_float(qf.y & 0xFFFF0000u));
        *(float4*)(Qb + r * 68 + c4) = make_float4(__uint_as_float(qb.x << 16), __uint_as_float(qb.x & 0xFFFF0000u), __uint_as_float(qb.y << 16), __uint_as_float(qb.y & 0xFFFF0000u)); }
    __syncthreads();
    float o[4][2];
#pragma unroll
    for (int x = 0; x < 4; ++x) { o[x][0] = __uint_as_float(vf[x] << 16) + __uint_as_float(vb[x] << 16); o[x][1] = __uint_as_float(vf[x] & 0xFFFF0000u) + __uint_as_float(vb[x] & 0xFFFF0000u); }
    for (int d = 0; d < 64; d += 4) {
        float4 qf[4], qb[4];
#pragma unroll
        for (int x = 0; x < 4; ++x) { qf[x] = *(const float4*)(Qf + (r0 + x) * 68 + d); qb[x] = *(const float4*)(Qb + (63 - r0 - x) * 68 + d); }
        const float2 sf0 = *(const float2*)(Sf + (d + 0) * 64 + c0), sf1 = *(const float2*)(Sf + (d + 1) * 64 + c0), sf2 = *(const float2*)(Sf + (d + 2) * 64 + c0), sf3 = *(const float2*)(Sf + (d + 3) * 64 + c0);
        const float2 sb0 = *(const float2*)(Sb + (d + 0) * 64 + c0), sb1 = *(const float2*)(Sb + (d + 1) * 64 + c0), sb2 = *(const float2*)(Sb + (d + 2) * 64 + c0), sb3 = *(const float2*)(Sb + (d + 3) * 64 + c0);
#pragma unroll
        for (int x = 0; x < 4; ++x) {
            o[x][0] += qf[x].x * sf0.x + qf[x].y * sf1.x + qf[x].z * sf2.x + qf[x].w * sf3.x + qb[x].x * sb0.x + qb[x].y * sb1.x + qb[x].z * sb2.x + qb[x].w * sb3.x;
            o[x][1] += qf[x].x * sf0.y + qf[x].y * sf1.y + qf[x].z * sf2.y + qf[x].w * sf3.y + qb[x].x * sb0.y + qb[x].y * sb1.y + qb[x].z * sb2.y + qb[x].w * sb3.y; }
    }
    const float nw0 = inp(p, 26)[l * 64 + c0], nw1 = inp(p, 26)[l * 64 + c0 + 1];
#pragma unroll
    for (int x = 0; x < 4; ++x) { float ss = o[x][0] * o[x][0] + o[x][1] * o[x][1];
        ss += __shfl_xor(ss, 1); ss += __shfl_xor(ss, 2); ss += __shfl_xor(ss, 4); ss += __shfl_xor(ss, 8); ss += __shfl_xor(ss, 16);
        const float rs = rsqrtf(ss * (1.f / 64.f) + EPS); const size_t row = (size_t)(rowbase + r0 + x);
        const float z0 = __uint_as_float(zv[x] << 16), z1 = __uint_as_float(zv[x] & 0xFFFF0000u);
        *(unsigned*)(Y + row * YK + 1024 + h * 64 + c0) = pk2(o[x][0] * rs * nw0 * siluf(z0), o[x][1] * rs * nw1 * siluf(z1)); }
    __syncthreads();
}

DEVI void phase_final(const Params& p) {
    const int tid = otid(); const int lane = tid & 63; const int gw = obx() * 8 + (tid >> 6), ngw = ogd() * 8;
    const float4* nw4 = (const float4*)inp(p, 27);
    float4 w4[4];
#pragma unroll
    for (int q = 0; q < 4; ++q) w4[q] = nw4[lane + 64 * q];
    for (int row = gw; row < T; row += ngw) {
        float4* r4 = (float4*)(outp(p) + (size_t)row * D);
        float4 v[4]; float ss = 0.f;
#pragma unroll
        for (int q = 0; q < 4; ++q) { v[q] = r4[lane + 64 * q]; ss += v[q].x * v[q].x + v[q].y * v[q].y + v[q].z * v[q].z + v[q].w * v[q].w; }
        ss = wave_sum(ss); const float rs = rsqrtf(ss * (1.f / 1024.f) + EPS);
#pragma unroll
        for (int q = 0; q < 4; ++q) r4[lane + 64 * q] = make_float4(v[q].x * rs * w4[q].x, v[q].y * rs * w4[q].y, v[q].z * rs * w4[q].z, v[q].w * rs * w4[q].w);
    }
}

#define XB_TMO      128
#define XB_XCNT(j)  (256  + 64 * (j))
#define XB_XSUB(j)  (1280 + 64 * (j))
#define XB_XGEN(j)  (2304 + 64 * (j))
#define XB_TOP      3328
#define XB_TOPGEN   3392
#define XCD_BAR_WORDS 3456
#define XB_SPIN_CAP (1u << 18)
#define LAS __attribute__((address_space(3)))

__device__ __forceinline__ unsigned xb_ld(unsigned* p)              { return __hip_atomic_load(p, __ATOMIC_RELAXED, __HIP_MEMORY_SCOPE_AGENT); }
__device__ __forceinline__ unsigned xb_add(unsigned* p, unsigned v) { return __hip_atomic_fetch_add(p, v, __ATOMIC_RELAXED, __HIP_MEMORY_SCOPE_AGENT); }
__device__ __forceinline__ unsigned xb_xcc_id() { return (unsigned)__builtin_amdgcn_s_getreg((3 << 11) | 20) & 0xFu; }
#define XB_SPIN(cond, bar) do { unsigned _sp = 0; while (cond) { __builtin_amdgcn_s_sleep(1); \
    if ((++_sp & 255u) == 0u) { if (xb_ld(&(bar)[XB_TMO])) break; if (_sp > XB_SPIN_CAP) { atomicAdd(&(bar)[XB_TMO], 1u); break; } } } } while (0)

struct XcdBarrier {
    unsigned* bar; unsigned x;
    volatile LAS unsigned* st;
};

__device__ __forceinline__ XcdBarrier xcd_barrier_post(unsigned* bar, volatile LAS unsigned* st) {
    XcdBarrier b; b.bar = bar; b.x = xb_xcc_id(); b.st = st;
    if (threadIdx.x == 0) (void)xb_add(&bar[XB_XCNT(b.x)], 1u);
    return b;
}
__device__ __forceinline__ void xcd_barrier_complete(unsigned* bar, unsigned x, unsigned& nloc, unsigned& nx) {
    const unsigned G = gridDim.x * gridDim.y * gridDim.z;
    unsigned sum, cnt, mine, sp = 0u;
    for (;;) {
        sum = 0u; cnt = 0u; mine = 0u;
#pragma unroll
        for (unsigned j = 0; j < 16; ++j) { const unsigned c = xb_ld(&bar[XB_XCNT(j)]); sum += c; cnt += (c > 0u) ? 1u : 0u; mine = (j == x) ? c : mine; }
        if (sum == G) break;
        __builtin_amdgcn_s_sleep(1);
        if ((++sp & 255u) == 0u) { if (xb_ld(&bar[XB_TMO])) break; if (sp > XB_SPIN_CAP) { atomicAdd(&bar[XB_TMO], 1u); break; } }
    }
    nloc = mine > 0u ? mine : 1u; nx = cnt > 0u ? cnt : 1u;
}

__device__ __forceinline__ void xcd_barrier(const XcdBarrier& b) {
    asm volatile("s_waitcnt vmcnt(0)" ::: "memory");
    __syncthreads();
    if (threadIdx.x == 0) {
        unsigned* bar = b.bar;
        __builtin_amdgcn_s_waitcnt(0);
        unsigned nloc = b.st[0], nx = b.st[1];
        if (nloc == 0u) { xcd_barrier_complete(bar, b.x, nloc, nx); b.st[0] = nloc; b.st[1] = nx; }
        const unsigned old = xb_add(&bar[XB_XSUB(b.x)], 1u);
        const unsigned gen = old / nloc;
        if (old + 1u == (gen + 1u) * nloc) {
            __builtin_amdgcn_fence(__ATOMIC_RELEASE, "agent");
            asm volatile("s_waitcnt vmcnt(0)" ::: "memory");
            const unsigned og = xb_add(&bar[XB_TOP], 1u);
            const unsigned tg = og / nx;
            if (og + 1u == (tg + 1u) * nx) xb_add(&bar[XB_TOPGEN], 1u);
            else XB_SPIN(xb_ld(&bar[XB_TOPGEN]) == tg, bar);
            __builtin_amdgcn_fence(__ATOMIC_ACQUIRE, "agent");
            xb_add(&bar[XB_XGEN(b.x)], 1u);
            asm volatile("s_waitcnt vmcnt(0)" ::: "memory");
        } else {
            XB_SPIN(xb_ld(&bar[XB_XGEN(b.x)]) == gen, bar);
            __builtin_amdgcn_fence(__ATOMIC_ACQUIRE, "agent");
            asm volatile("s_waitcnt vmcnt(0)" ::: "memory");
        }
    }
    __syncthreads();
}


#ifndef MK_ALIGN
#define MK_ALIGN true
#endif
#ifndef MK_SP2
#define MK_SP2 true
#endif
constexpr int N_PHASES = 2 + 12 * NLAYER;
__global__ void __launch_bounds__(512, 2) mega_fwd(Params p) {
    extern __shared__ __attribute__((aligned(16))) unsigned char lds[];
    float* sm = (float*)lds;
    PG8_LAS unsigned char* glds = (PG8_LAS unsigned char*)lds;
    cg::grid_group grid = cg::this_grid();
    volatile LAS unsigned* xst = (volatile LAS unsigned*)(lds + LDS_BYTES - 16);
    if (threadIdx.x == 0) { xst[0] = 0u; xst[1] = 0u; }
    __syncthreads();
    const XcdBarrier xb = xcd_barrier_post((unsigned*)(p.ws + WS_BAR), xst);
    pg8::StaticOrder S;
    int rep_done = 0;
#pragma unroll 1
    for (int ph = p.ph_lo; ph < p.ph_hi; ++ph) {
        unsigned char* const ws = opq(p.ws);
        if (ph == 0) { if (!(SKIPM & 1)) phase_init(p, sm); }
        else if (ph == N_PHASES - 1) phase_final(p);
        else {
            const int l = (ph - 1) / 12, s = (ph - 1) % 12;
            if (s == 3 || s == 9) continue;
            const float* MODL = (const float*)(ws + WS_MOD) + (size_t)l * 3 * 9216;
            switch (s) {
            case 0: if (!(SKIPM & 2)) phase_prep(p, l, sm); break;
            case 1: case 10: if (!(SKIPM & 4)) {
                const int Mup = (s == 10 && l == NLAYER - 1) ? T : MROWS;
                S.init(Mup, 2 * FH, ogd(), obx());
                pg8::Gemm g{(const bf16_t*)(ws + (s == 1 ? WS_NY : WS_GD)), (const bf16_t*)(ws + (s == 1 ? WS_WUP1 : WS_WUP2)), Mup, 2 * FH, 1024};
                EpiUp E{(bf16_t*)(ws + WS_H), (const float*)(ws + WS_RS + (s == 1 ? 0 : 2) * RS_STRIDE), (const float*)(ws + WS_BIAS) + (size_t)(s == 1 ? 0 : 2) * 3 * 5632};
                pg8::gemm_phase<decltype(E), pg8::StaticOrder, MK_ALIGN, MK_SP2>(glds, g, S, E); } break;
            case 2: case 8: case 11: if (!(SKIPM & 8)) {
                const int K = s == 8 ? YK : FH;
                const bf16_t* A = (const bf16_t*)(ws + (s == 8 ? WS_NY : WS_H)); const bf16_t* W = (const bf16_t*)(ws + (s == 2 ? WS_WDN1 : s == 8 ? WS_WOUT : WS_WDN2));
                const float* gate = MODL + (s == 2 ? 2 : s == 8 ? 5 : 8) * 1024; const float mult = s == 8 ? 1.f : 0.5f;
                S.init(T, 1024, ogd(), obx());
                pg8::Gemm g{A, W, T, 1024, K};
                const bool feeds = !(s == 11 && l == NLAYER - 1);
                bf16_t* nyraw = feeds ? (bf16_t*)(ws + (s == 8 ? WS_GD : WS_NY)) : nullptr; float* rsacc = (float*)(ws + WS_RS + (s == 2 ? 1 : s == 8 ? 2 : 0) * RS_STRIDE);
                const int nl = s == 11 ? l + 1 : l, nwhich = s == 2 ? 1 : s == 8 ? 2 : 0;
                const float* nw = inp(p, 6) + ((size_t)(feeds ? nl : l) * 3 + nwhich) * 1024; const float* nscale = (const float*)(ws + WS_MOD) + (size_t)(feeds ? nl : l) * 3 * 9216 + (3 * nwhich + 1) * 1024;
                const bool first = (l == 0 && s == 2);
                const EpiRes E{outp(p), (float*)(ws + WS_CTXR), first ? inp(p, 0) : (const float*)outp(p), gate, nyraw, rsacc, nw, nscale, mult, feeds ? 1 : 0};
                pg8::gemm_phase<decltype(E), pg8::StaticOrder, MK_ALIGN, MK_SP2>(glds, g, S, E);
                if (!(l == NLAYER - 1 && s != 2)) mini_res(p, A, W, K, gate, mult, nyraw, rsacc, nw, nscale, first ? inp(p, 2) : (const float*)(ws + WS_CTXR), sm); } break;
            case 4: if (!(SKIPM & 16)) {
                S.init(MROWS, PN, ogd(), obx());
                pg8::Gemm g{(const bf16_t*)(ws + WS_NY), (const bf16_t*)(ws + WS_WIN), MROWS, PN, 1024};
                EpiP E{(bf16_t*)(ws + WS_P), (const float*)(ws + WS_RS + RS_STRIDE), (const float*)(ws + WS_BIAS) + (size_t)3 * 5632};
                pg8::gemm_phase<decltype(E), pg8::StaticOrder, MK_ALIGN, MK_SP2>(glds, g, S, E);
                { float* RS0 = (float*)(ws + WS_RS); float* RS2 = (float*)(ws + WS_RS + 2 * RS_STRIDE);
                  for (int i = obx() * 512 + otid(); i < MROWS; i += ogd() * 512) { RS0[i] = 0.f; RS2[i] = 0.f; } } } break;
            case 5: if (!(SKIPM & 32)) phase_m1(p, l, sm); break;
            case 6: if (!(SKIPM & 64)) phase_m2(p, l, sm); break;
            case 7: if (!(SKIPM & 128)) {
                if (l == NLAYER - 1) { for (int it = obx(); it < 2048; it += ogd()) g3_item(p, l, (it >> 8) * NCH + 4 + (it & 255), sm); }
                else for (int it = obx(); it < 2 * 4 * NCH; it += ogd()) g3_item(p, l, it, sm); } break;
            }
        }
#if REPM
        {
            const int s_ = (ph >= 1 && ph < N_PHASES - 1) ? (ph - 1) % 12 : -1;
            if (s_ >= 0) {
                if (((REPM >> s_) & 1) && s_ != 6) { if (!rep_done) { rep_done = 1; --ph; } else rep_done = 0; }
                if ((REPM & 4096) && s_ == 6) { if (!rep_done) { rep_done = 1; ph -= 2; } else rep_done = 0; }
            }
        }
#endif
        if (ph + 1 < p.ph_hi) { if (p.ph_lo < 0) grid.sync(); else xcd_barrier(xb); }
    }
}

#ifndef MK_PER_PHASE
#define MK_PER_PHASE 0
#endif
extern "C" void kernel_launch(void* const* d_in, const int* in_sizes, int n_in, void* d_out, int out_size, void* d_ws, size_t ws_size, hipStream_t stream) {
    static int grid = 0;
    if (grid == 0) {
        if (n_in != 28 || out_size != T * D || ws_size < WS_TOTAL) { fprintf(stderr, "kernel_launch: unexpected shapes (n_in %d, out %d, ws %zu < %zu)\n", n_in, out_size, ws_size, (size_t)WS_TOTAL); grid = -1; return; }
        int dev = 0, cus = 0, per_cu = 0;
        (void)hipGetDevice(&dev); (void)hipDeviceGetAttribute(&cus, hipDeviceAttributeMultiprocessorCount, dev);
        if (hipFuncSetAttribute((const void*)mega_fwd, hipFuncAttributeMaxDynamicSharedMemorySize, LDS_BYTES) != hipSuccess) { fprintf(stderr, "kernel_launch: hipFuncSetAttribute failed\n"); grid = -1; return; }
        if (hipOccupancyMaxActiveBlocksPerMultiprocessor(&per_cu, (const void*)mega_fwd, 512, LDS_BYTES) != hipSuccess || per_cu < 1) { fprintf(stderr, "kernel_launch: occupancy query says %d\n", per_cu); per_cu = 1; }
        (void)hipGetLastError();
        grid = cus * 1;
        if (grid < 128) { fprintf(stderr, "kernel_launch: %d CUs?\n", grid); grid = -1; return; }
    }
    if (grid < 0) return;
    Params p{};
    for (int i = 0; i < 28; ++i) p.in[i] = (const float*)d_in[i];
    p.out = (float*)d_out; p.ws = (unsigned char*)d_ws;
#if MK_PER_PHASE
    for (int ph = 0; ph < N_PHASES; ++ph) { p.ph_lo = ph; p.ph_hi = ph + 1; hipLaunchKernelGGL(mega_fwd, dim3(grid), dim3(512), LDS_BYTES, stream, p); }
#else
    p.ph_lo = 0; p.ph_hi = N_PHASES;
    (void)hipMemsetAsync((unsigned char*)d_ws + WS_BAR, 0, XCD_BAR_WORDS * sizeof(unsigned), stream);
    void* args[] = {&p};
    const hipError_t e = hipLaunchCooperativeKernel((const void*)mega_fwd, dim3(grid), dim3(512), args, LDS_BYTES, stream);
    if (e != hipSuccess) fprintf(stderr, "kernel_launch: cooperative launch failed: %s (grid %d)\n", hipGetErrorString(e), grid);
#endif
}
```

```cpp
#define M2_CONV 1
#define M2_POOL 1
#include <hip/hip_runtime.h>
#include <hip/hip_cooperative_groups.h>
#include <cstdio>
namespace cg = cooperative_groups;
#define DEVI __device__ __forceinline__
namespace pg8 {
#define PG8_LAS __attribute__((address_space(3)))
typedef unsigned short bf16_t;
typedef short bf16x8 __attribute__((ext_vector_type(8)));
typedef float f32x4 __attribute__((ext_vector_type(4)));
typedef unsigned u32x4 __attribute__((ext_vector_type(4)));
constexpr int BM = 256, BK = 64, HALF = 128, HTB = HALF * BK * 2  , STAGE_BYTES = 8 * HTB, NXCD = 8, WGM = 8;

__host__ __device__ __forceinline__ int lds_byte(int r, int c) { const int st = (r >> 4) * 2 + (c >> 5), rr = r & 15, cc = c & 31, ob = rr * 64 + cc * 2; return st * 1024 + (ob ^ (((ob >> 9) & 1) << 5)); }
__host__ __device__ __forceinline__ void stage_rc(int b, int& R, int& C) { const int st = b / 1024, sb = b % 1024, swz = sb ^ (((sb >> 9) & 1) << 5); R = (st >> 1) * 16 + swz / 64; C = (st & 1) * 32 + (swz % 64) / 2; }
__host__ __device__ __forceinline__ int perm32(int rho) { const int n = rho >> 4, i = rho & 15; return 8 * (i >> 2) + 4 * n + (i & 3); }

struct Unit { int pm, pn; };
struct Gemm { const bf16_t* A; const bf16_t* Bt; int M, N, K; };
struct StaticOrder {
    int nM, nN, nwg, G, c;
    __host__ __device__ void init(int M, int N, int G_, int c_) { nM = M / BM; nN = N / BM; nwg = nM * nN; G = G_; c = c_; }
    __host__ __device__ bool next(int i, Unit& u) const {
        const long L = (long)i * G + c; if (L >= nwg) return false;
        int wgid = (int)L; { const int q = nwg / NXCD, r = nwg % NXCD, xcd = wgid % NXCD, off = wgid / NXCD; wgid = (xcd < r ? xcd * (q + 1) : r * (q + 1) + (xcd - r) * q) + off; }
        const int nig = WGM * nN, gid = wgid / nig, fm = gid * WGM, gsz = (nM - fm) < WGM ? (nM - fm) : WGM;
        u.pm = fm + ((wgid % nig) % gsz); u.pn = (wgid % nig) / gsz; return true;
    }
    __device__ __forceinline__ void a_ready(const Unit&) const {}
    __device__ __forceinline__ void done(const Unit&) const {}
};
__device__ __forceinline__ unsigned cvt_pk_bf16(float lo, float hi) { unsigned r; asm volatile("v_cvt_pk_bf16_f32 %0, %1, %2" : "=v"(r) : "v"(lo), "v"(hi)); return r; }
template <class Epi, class Sched, bool ALIGN_EPI = false, bool SP2 = false>
__device__ __forceinline__ void gemm_phase(PG8_LAS unsigned char* lds, const Gemm g, const Sched& S, const Epi& E) {
    int tid_ = threadIdx.x; asm volatile("" : "+v"(tid_));
    const int tid = tid_, wid = __builtin_amdgcn_readfirstlane(tid >> 6), lane = tid & 63, wr = wid >> 2, wc = wid & 3, fr = lane & 15, fq = lane >> 4;
    const int K = g.K, nt = K / BK;
    unsigned voffA[2], voffB[2];
#pragma unroll
    for (int i = 0; i < 2; ++i) { int R, C; stage_rc(tid * 16 + i * 8192, R, C); const int Rb = Epi::PERM ? ((R & ~31) + perm32(R & 31)) : R;
        voffA[i] = (unsigned)(R * K + C) * 2u; voffB[i] = (unsigned)(Rb * K + C) * 2u; }
    const size_t kstep = (size_t)(BK * 2);
    const size_t hstep = (size_t)HALF * K * 2;
    const size_t tstep = 2 * hstep;
    const unsigned ldsw = (unsigned)wid * 1024u;
    const int aoff = lds_byte(wr * 64 + fr, fq * 8), boff = lds_byte(wc * 32 + fr, fq * 8);
#define PG8_SA(b, h) (((b) * 2 + (h)) * HTB)
#define PG8_SB(b, h) ((4 + (b) * 2 + (h)) * HTB)
#define PG8_STAGE(bufoff, gbase, voff) do { _Pragma("unroll") for (int _i = 0; _i < 2; ++_i) \
        __builtin_amdgcn_global_load_lds((const unsigned*)((const char*)(gbase) + (voff)[_i]), (PG8_LAS unsigned*)(lds + (bufoff) + ldsw + _i * 8192), 16, 0, 0); } while (0)
#define PG8_LDA(dst, b, h) do { _Pragma("unroll") for (int m = 0; m < 4; ++m) _Pragma("unroll") for (int k = 0; k < 2; ++k) dst[m][k] = *(const PG8_LAS bf16x8*)(lds + PG8_SA(b, h) + aoff + m * 2048 + k * 1024); } while (0)
#define PG8_LDB(dst, b, h) do { _Pragma("unroll") for (int n = 0; n < 2; ++n) _Pragma("unroll") for (int k = 0; k < 2; ++k) dst[n][k] = *(const PG8_LAS bf16x8*)(lds + PG8_SB(b, h) + boff + n * 2048 + k * 1024); } while (0)
#define PG8_MMA(ai, bj, At, Bt) do { __builtin_amdgcn_s_setprio(1); _Pragma("unroll") for (int m = 0; m < 4; ++m) _Pragma("unroll") for (int n = 0; n < 2; ++n) _Pragma("unroll") for (int k = 0; k < 2; ++k) \
        acc[ai][bj][m][n] = __builtin_amdgcn_mfma_f32_16x16x32_bf16(Bt[n][k], At[m][k], acc[ai][bj][m][n], 0, 0, 0); __builtin_amdgcn_s_setprio(0); } while (0)
#define PG8_WAIT_V(n) asm volatile("s_waitcnt vmcnt(" #n ")" ::: "memory")
#define PG8_WAIT_L(n) asm volatile("s_waitcnt lgkmcnt(" #n ")" ::: "memory")
#define PG8_BAR __builtin_amdgcn_s_barrier()
#define PG8_SCHED __builtin_amdgcn_sched_barrier(0)
    Unit cur, nxt; int ui = 0;
    if (!S.next(0, cur)) return;
    f32x4 acc[2][2][4][2];
#pragma unroll
    for (int a = 0; a < 2; ++a)
#pragma unroll
        for (int b = 0; b < 2; ++b)
#pragma unroll
            for (int m = 0; m < 4; ++m)
#pragma unroll
                for (int n = 0; n < 2; ++n) acc[a][b][m][n] = (f32x4){0.f, 0.f, 0.f, 0.f};
    bf16x8 At[4][2], B0[2][2], B1[2][2];
    const char* cA = (const char*)g.A + (size_t)cur.pm * tstep; const char* cB = (const char*)g.Bt + (size_t)cur.pn * tstep;
    S.a_ready(cur);
    if constexpr (SP2) {
        PG8_STAGE(PG8_SB(0, 0), cB, voffB); PG8_STAGE(PG8_SB(0, 1), cB + hstep, voffB); PG8_STAGE(PG8_SA(0, 0), cA, voffA); PG8_STAGE(PG8_SA(0, 1), cA + hstep, voffA);
        if (wr == 1) PG8_BAR;
        PG8_WAIT_V(2); PG8_BAR;
        PG8_STAGE(PG8_SB(1, 0), cB + kstep, voffB); PG8_STAGE(PG8_SA(1, 0), cA + kstep, voffA); PG8_STAGE(PG8_SB(1, 1), cB + hstep + kstep, voffB);
        PG8_WAIT_V(6); PG8_BAR;
    } else {
        PG8_STAGE(PG8_SB(0, 0), cB, voffB); PG8_STAGE(PG8_SA(0, 0), cA, voffA); PG8_STAGE(PG8_SB(0, 1), cB + hstep, voffB); PG8_STAGE(PG8_SA(0, 1), cA + hstep, voffA);
        if (wr == 1) PG8_BAR;
        PG8_WAIT_V(4); PG8_BAR;
        PG8_STAGE(PG8_SB(1, 0), cB + kstep, voffB); PG8_STAGE(PG8_SA(1, 0), cA + kstep, voffA); PG8_STAGE(PG8_SB(1, 1), cB + hstep + kstep, voffB);
        PG8_WAIT_V(6); PG8_BAR;
    }
    for (;;) {
        const bool has_next = S.next(ui + 1, nxt);
        const char* nA = has_next ? (const char*)g.A + (size_t)nxt.pm * tstep : cA; const char* nB = has_next ? (const char*)g.Bt + (size_t)nxt.pn * tstep : cB;
        for (int t = 0; t < nt; t += 2) {
            const bool last = (t == nt - 2);
            const char* a1 = cA + (size_t)(t + 1) * kstep;
            const char* a2 = last ? nA : cA + (size_t)(t + 2) * kstep; const char* b2 = last ? nB : cB + (size_t)(t + 2) * kstep;
            const char* a3 = a2 + kstep; const char* b3 = b2 + kstep;
            if (last && has_next) S.a_ready(nxt);
            if constexpr (SP2) {
            PG8_LDB(B0, 0, 0); PG8_LDB(B1, 0, 1); PG8_SCHED; PG8_LDA(At, 0, 0); PG8_STAGE(PG8_SA(1, 1), a1 + hstep, voffA);
            PG8_WAIT_V(8); PG8_WAIT_L(0); PG8_BAR; PG8_MMA(0, 0, At, B0); PG8_MMA(0, 1, At, B1); PG8_BAR; PG8_SCHED;
            PG8_LDA(At, 0, 1); PG8_STAGE(PG8_SB(0, 0), b2, voffB); PG8_STAGE(PG8_SB(0, 1), b2 + hstep, voffB); PG8_STAGE(PG8_SA(0, 0), a2, voffA);
            PG8_WAIT_V(8); PG8_WAIT_L(0); PG8_BAR; PG8_MMA(1, 0, At, B0); PG8_MMA(1, 1, At, B1); PG8_BAR; PG8_SCHED;
            PG8_LDB(B0, 1, 0); PG8_LDB(B1, 1, 1); PG8_SCHED; PG8_LDA(At, 1, 0); PG8_STAGE(PG8_SA(0, 1), a2 + hstep, voffA);
            PG8_WAIT_V(8); PG8_WAIT_L(0); PG8_BAR; PG8_MMA(0, 0, At, B0); PG8_MMA(0, 1, At, B1); PG8_BAR; PG8_SCHED;
            PG8_LDA(At, 1, 1); PG8_STAGE(PG8_SB(1, 0), b3, voffB); PG8_STAGE(PG8_SB(1, 1), b3 + hstep, voffB); PG8_STAGE(PG8_SA(1, 0), a3, voffA);
            PG8_WAIT_V(8); PG8_WAIT_L(0); PG8_BAR; PG8_MMA(1, 0, At, B0); PG8_MMA(1, 1, At, B1); PG8_BAR; PG8_SCHED;
            } else {
            PG8_LDB(B0, 0, 0); PG8_SCHED; PG8_LDA(At, 0, 0); PG8_STAGE(PG8_SA(1, 1), a1 + hstep, voffA);
            PG8_WAIT_L(8); PG8_BAR; PG8_WAIT_L(0); PG8_MMA(0, 0, At, B0); PG8_BAR; PG8_SCHED;
            PG8_LDB(B1, 0, 1); PG8_STAGE(PG8_SB(0, 0), b2, voffB);
            PG8_BAR; PG8_WAIT_L(0); PG8_MMA(0, 1, At, B1); PG8_BAR;
            PG8_LDA(At, 0, 1); PG8_STAGE(PG8_SA(0, 0), a2, voffA);
            PG8_BAR; PG8_WAIT_L(0); PG8_MMA(1, 0, At, B0); PG8_BAR; PG8_SCHED;
            PG8_STAGE(PG8_SB(0, 1), b2 + hstep, voffB);
            PG8_WAIT_V(6); PG8_BAR; PG8_MMA(1, 1, At, B1); PG8_BAR;
            PG8_LDB(B0, 1, 0); PG8_SCHED; PG8_LDA(At, 1, 0); PG8_STAGE(PG8_SA(0, 1), a2 + hstep, voffA);
            PG8_WAIT_L(8); PG8_BAR; PG8_WAIT_L(0); PG8_MMA(0, 0, At, B0); PG8_BAR; PG8_SCHED;
            PG8_LDB(B1, 1, 1); PG8_STAGE(PG8_SB(1, 0), b3, voffB);
            PG8_BAR; PG8_WAIT_L(0); PG8_MMA(0, 1, At, B1); PG8_BAR;
            PG8_LDA(At, 1, 1); PG8_STAGE(PG8_SA(1, 0), a3, voffA);
            PG8_BAR; PG8_WAIT_L(0); PG8_MMA(1, 0, At, B0); PG8_BAR; PG8_SCHED;
            PG8_STAGE(PG8_SB(1, 1), b3 + hstep, voffB);
            PG8_WAIT_V(6); PG8_BAR; PG8_MMA(1, 1, At, B1); PG8_BAR;
            }
        }
        if constexpr (ALIGN_EPI) { if (wr == 0) PG8_BAR; }
        if constexpr (!Epi::AFTER_DRAIN) { E(acc, cur, wr, wc, fr, fq); S.done(cur); }
        if (!has_next) break;
#pragma unroll
        for (int a = 0; a < 2; ++a)
#pragma unroll
            for (int b = 0; b < 2; ++b)
#pragma unroll
                for (int m = 0; m < 4; ++m)
#pragma unroll
                    for (int n = 0; n < 2; ++n) acc[a][b][m][n] = (f32x4){0.f, 0.f, 0.f, 0.f};
        cur = nxt; cA = nA; cB = nB; ++ui;
        if constexpr (ALIGN_EPI) { if (wr == 1) PG8_BAR; }
    }
    PG8_WAIT_V(0);
    if constexpr (!ALIGN_EPI) { if (wr == 0) PG8_BAR; }
    PG8_BAR;
    if constexpr (Epi::AFTER_DRAIN) { E.fused(acc, cur, wr, wc, fr, fq, lds, wid, lane); S.done(cur); }
#undef PG8_SA
#undef PG8_SB
#undef PG8_STAGE
#undef PG8_LDA
#undef PG8_LDB
#undef PG8_MMA
#undef PG8_WAIT_V
#undef PG8_WAIT_L
#undef PG8_BAR
#undef PG8_SCHED
}
}
#ifndef SKIPM
#define SKIPM 0
#endif
#ifndef REPM
#define REPM 0
#endif
using pg8::bf16_t; using pg8::f32x4; using pg8::u32x4; using pg8::Unit;

constexpr int D = 1024, SEQ = 16384, T = 32768, TC = 512, MROWS = 33280, FH = 2816, NLAYER = 4;
constexpr int PPITCH = 2080, PN = 2304, YK = 1280, NCH = 260;
constexpr float EPS = 1e-6f;
constexpr size_t WS_WUP1 = 0;
constexpr size_t WS_WDN1 = WS_WUP1 + (size_t)5632 * 1024 * 2;
constexpr size_t WS_WUP2 = WS_WDN1 + (size_t)1024 * 2816 * 2;
constexpr size_t WS_WDN2 = WS_WUP2 + (size_t)5632 * 1024 * 2;
constexpr size_t WS_WIN  = WS_WDN2 + (size_t)1024 * 2816 * 2;
constexpr size_t WS_WOUT = WS_WIN + (size_t)PN * 1024 * 2;
constexpr size_t WS_MOD  = WS_WOUT + (size_t)1024 * YK * 2;
constexpr size_t WS_CF   = WS_MOD + (size_t)4 * 3 * 9216 * 4;
constexpr size_t WS_CTXR = WS_CF + (size_t)4 * 2 * 65536 * 4;
constexpr size_t WS_NY   = WS_CTXR + (size_t)TC * D * 4;
constexpr size_t WS_U    = WS_NY + (size_t)MROWS * YK * 2;
constexpr size_t WS_H    = WS_U;
constexpr size_t WS_P    = WS_U;
constexpr size_t WS_FS   = WS_P + (size_t)MROWS * PPITCH * 2;
constexpr size_t WS_GD   = WS_FS + (size_t)2 * 16384 * 256 * 8;
constexpr size_t GD_REC_F = 12288;
constexpr size_t WS_END  = WS_GD + (size_t)16 * NCH * GD_REC_F * 4;
static_assert(WS_U + (size_t)MROWS * FH * 2 <= WS_END, "H fits");
constexpr size_t WS_BAR = WS_END;
constexpr size_t WS_RS = WS_BAR + 16384;
constexpr size_t RS_STRIDE = (size_t)MROWS * 4;
constexpr size_t WS_BIAS = WS_RS + 3 * RS_STRIDE;
constexpr size_t WS_TOTAL = WS_BIAS + (size_t)3 * 3 * 5632 * 4;
constexpr int LDS_BYTES = 160 * 1024;
constexpr int TAB_OFF = 32768;

struct Params { const float* in[28]; float* out; unsigned char* ws; int ph_lo, ph_hi; };

#define GASP __attribute__((address_space(1)))
DEVI unsigned char* opq(unsigned char* x) { GASP unsigned char* g = (GASP unsigned char*)x; asm volatile("" : "+s"(g)); return (unsigned char*)g; }
DEVI const float* inp(const Params& p, int i) { asm volatile("" : "+s"(i)); GASP const float* g = (GASP const float*)p.in[i]; asm volatile("" : "+s"(g)); return (const float*)g; }
DEVI float* outp(const Params& p) { GASP float* g = (GASP float*)p.out; asm volatile("" : "+s"(g)); return (float*)g; }
DEVI int obx() { int b = blockIdx.x; asm volatile("" : "+s"(b)); return b; }
DEVI int ogd() { int b = gridDim.x; asm volatile("" : "+s"(b)); return b; }
DEVI int otid() { int t = threadIdx.x; asm volatile("" : "+v"(t)); return t; }
DEVI float bf2f(unsigned short b) { return __uint_as_float(((unsigned)b) << 16); }
DEVI unsigned pk2(float a, float b) { unsigned r; asm("v_cvt_pk_bf16_f32 %0, %1, %2" : "=v"(r) : "v"(a), "v"(b)); return r; }
DEVI unsigned short f2bf(float f) { return (unsigned short)(pk2(f, 0.f) & 0xFFFFu); }
DEVI float sigmf(float x) { return __builtin_amdgcn_rcpf(1.f + __expf(-x)); }
DEVI float siluf(float x) { return x * sigmf(x); }
DEVI float wave_sum(float v) {
#pragma unroll
    for (int o = 1; o < 64; o <<= 1) v += __shfl_xor(v, o);
    return v;
}
#define UNPACK8(v, f) do { (f)[0] = __uint_as_float((v).x << 16); (f)[1] = __uint_as_float((v).x & 0xFFFF0000u); (f)[2] = __uint_as_float((v).y << 16); (f)[3] = __uint_as_float((v).y & 0xFFFF0000u); \
    (f)[4] = __uint_as_float((v).z << 16); (f)[5] = __uint_as_float((v).z & 0xFFFF0000u); (f)[6] = __uint_as_float((v).w << 16); (f)[7] = __uint_as_float((v).w & 0xFFFF0000u); } while (0)
DEVI float* res_row(const Params& p, int row) { return row < T ? outp(p) + (size_t)row * D : (float*)(opq(p.ws) + WS_CTXR) + (size_t)(row - T) * D; }

DEVI void phase_init(const Params& p, float* sm) { unsigned char* const ws = opq(p.ws);
    const int tid = otid(), lane = tid & 63, wv = tid >> 6;
    const size_t gt = (size_t)obx() * 512 + tid, gs = (size_t)ogd() * 512;
    float* sv = sm;
    float* red = sm + 3072;
    float* tc = sm + 3072 + 1536;
    for (int i = tid; i < 3072; i += 512) { const float v = i < 2048 ? inp(p, 1)[i] : inp(p, 3)[i - 2048]; sv[i] = siluf(v); }
    if (tid < 64) { float s, c; sincospif((float)tid * (1.f / 32.f), &s, &c); tc[tid] = c; tc[64 + tid] = s; }
    __syncthreads();
    const float* mw = inp(p, 4); const float* mb = inp(p, 5); float* MOD = (float*)(ws + WS_MOD);
    for (int item = obx(); item < 576; item += ogd()) {
        const int gc = item * 64 + lane, l = gc / 9216, j = gc - l * 9216;
        const float* w = mw + ((size_t)l * 1024 + wv * 128) * 9216 + j;
        float a0 = 0.f, a1 = 0.f, a2 = 0.f;
#pragma unroll 8
        for (int k = 0; k < 128; ++k) { const float x = w[(size_t)k * 9216]; const int kk = wv * 128 + k; a0 += sv[kk] * x; a1 += sv[1024 + kk] * x; a2 += sv[2048 + kk] * x; }
        red[(wv * 3 + 0) * 64 + lane] = a0; red[(wv * 3 + 1) * 64 + lane] = a1; red[(wv * 3 + 2) * 64 + lane] = a2;
        __syncthreads();
        if (tid < 192) { const int r = tid >> 6; float s = mb[(size_t)l * 9216 + j];
#pragma unroll
            for (int w8 = 0; w8 < 8; ++w8) s += red[(w8 * 3 + r) * 64 + lane];
            MOD[((size_t)l * 3 + r) * 9216 + j] = s; }
        __syncthreads();
    }
    const float* fw = inp(p, 17); float* CF = (float*)(ws + WS_CF);
    for (size_t idx = gt; idx < 524288; idx += gs) {
        const int k = (int)(idx & 255), row = (int)((idx >> 8) & 255), t = (int)((idx >> 16) & 1), l = (int)(idx >> 17);
        const int g = row >> 6, c = row & 63;
        const float* f = fw + ((size_t)l * 256 + g * 64) * 256 + k; const float* tab = tc + t * 64; float s = 0.f;
        for (int m = 0; m < 64; ++m) s += tab[(c * m) & 63] * f[m * 256];
        CF[idx] = s;
    }
}

DEVI void transpose_wave(const float* src, int N, int k0, int n0, bf16_t* dst, int K, int drow0, float* scr, int lane) {
    float v[32]; const int n = n0 + (lane & 31);
#pragma unroll
    for (int i = 0; i < 32; ++i) v[i] = n < N ? src[(size_t)(k0 + 2 * i + (lane >> 5)) * N + n] : 0.f;
#pragma unroll
    for (int i = 0; i < 32; ++i) scr[(2 * i + (lane >> 5)) * 33 + (lane & 31)] = v[i];
    asm volatile("s_waitcnt lgkmcnt(0)" ::: "memory");
    const int c = lane & 7;
#pragma unroll
    for (int j = 0; j < 4; ++j) { const int nn = (lane >> 3) + 8 * j; const float* t = scr + (8 * c) * 33 + nn;
        uint4 o; o.x = pk2(t[0], t[33]); o.y = pk2(t[66], t[99]); o.z = pk2(t[132], t[165]); o.w = pk2(t[198], t[231]);
        *(uint4*)(dst + (size_t)(drow0 + nn) * K + k0 + 8 * c) = o; }
    asm volatile("s_waitcnt lgkmcnt(0)" ::: "memory");
}

DEVI void raw_rows(const Params& p) { unsigned char* const ws = opq(p.ws);
    const int tid = otid(); const int lane = tid & 63; const int gw = obx() * 8 + (tid >> 6), ngw = ogd() * 8;
    const float4* nw4 = (const float4*)inp(p, 6);
    const float* MOD = (const float*)(ws + WS_MOD);
    bf16_t* NY = (bf16_t*)(ws + WS_NY); float* RS0 = (float*)(ws + WS_RS);
    float4 w4[4];
#pragma unroll
    for (int q = 0; q < 4; ++q) w4[q] = nw4[lane + 64 * q];
    for (int row = gw; row < MROWS; row += ngw) {
        const float4* r4 = (const float4*)(row < T ? inp(p, 0) + (size_t)row * D : inp(p, 2) + (size_t)(row - T) * D); const int mr = row < SEQ ? 0 : (row < T ? 1 : 2);
        const float4* sc4 = (const float4*)(MOD + (size_t)mr * 9216 + 1024);
        float4 v[4]; float ss = 0.f;
#pragma unroll
        for (int q = 0; q < 4; ++q) { v[q] = r4[lane + 64 * q]; ss += v[q].x * v[q].x + v[q].y * v[q].y + v[q].z * v[q].z + v[q].w * v[q].w; }
        ss = wave_sum(ss); if (lane == 0) RS0[row] = ss;
#pragma unroll
        for (int q = 0; q < 4; ++q) { const float4 c = sc4[lane + 64 * q];
            uint2 o; o.x = pk2(v[q].x * w4[q].x * (1.f + c.x), v[q].y * w4[q].y * (1.f + c.y)); o.y = pk2(v[q].z * w4[q].z * (1.f + c.z), v[q].w * w4[q].w * (1.f + c.w));
            *(uint2*)(NY + (size_t)row * 1024 + (lane + 64 * q) * 4) = o; }
    }
}

DEVI void phase_prep(const Params& p, int l, float* sm) { unsigned char* const ws = opq(p.ws);
    const int tid = otid();
    constexpr int NT_UP = 16 * 88, NT_DN = 44 * 32, NT_IN = 16 * 65, TOTAL = 4 * NT_UP + 2 * NT_DN + NT_IN;
    { const int lane = tid & 63, wv = __builtin_amdgcn_readfirstlane(tid >> 6); float* scr = sm + wv * 2112;
      for (int it = obx() * 8 + wv; it < TOTAL; it += ogd() * 8) {
        int r = it;
        if (r < 4 * NT_UP) { const int which = r / NT_UP; r -= which * NT_UP; const int kt = r / 88, nt = r % 88;
            const float* src = inp(p, which == 0 ? 7 : which == 1 ? 8 : which == 2 ? 10 : 11) + (size_t)l * 1024 * FH;
            const int n0 = nt * 32, drow0 = 256 * (n0 >> 7) + 128 * (which & 1) + (n0 & 127);
            transpose_wave(src, FH, kt * 64, n0, (bf16_t*)(ws + ((which >> 1) ? WS_WUP2 : WS_WUP1)), 1024, drow0, scr, lane);
        } else if ((r -= 4 * NT_UP) < 2 * NT_DN) { const int which = r / NT_DN; r -= which * NT_DN; const int kt = r / 32, nt = r % 32;
            transpose_wave(inp(p, which ? 12 : 9) + (size_t)l * FH * 1024, 1024, kt * 64, nt * 32, (bf16_t*)(ws + (which ? WS_WDN2 : WS_WDN1)), FH, nt * 32, scr, lane);
        } else { r -= 2 * NT_DN; const int kt = r / 65, nt = r % 65;
            transpose_wave(inp(p, 13) + (size_t)l * 1024 * 2064, 2064, kt * 64, nt * 32, (bf16_t*)(ws + WS_WIN), 1024, nt * 32, scr, lane); }
      } }
    const float* wo = inp(p, 14) + (size_t)l * 1024 * 1024; bf16_t* WOUT = (bf16_t*)(ws + WS_WOUT);
    const float* CF = (const float*)(ws + WS_CF) + (size_t)l * 2 * 65536;
    for (int it = obx(); it < 320; it += ogd()) {
        const int ti = it * 512 + tid, j = ti & 1023, kk0 = (ti >> 10) * 8, region = kk0 >> 8, kl = kk0 & 255;
        float acc[8];
#pragma unroll
        for (int e = 0; e < 8; ++e) acc[e] = 0.f;
        if (region == 0) { const int g = kl >> 6, c0 = kl & 63; const float* pw = inp(p, 15) + (((size_t)l * 4 + g) * 64 + c0) * 64; const float* ps = inp(p, 16) + (size_t)l * 256 + g * 64;
#pragma unroll 8
            for (int t = 0; t < 64; ++t) { const float wv = wo[(size_t)(g * 64 + t) * 1024 + j] * ps[t];
#pragma unroll
                for (int e = 0; e < 8; ++e) acc[e] += pw[e * 64 + t] * wv; }
        } else if (region <= 3) { const float* Lm = (region == 3 ? inp(p, 22) + (size_t)l * 65536 : CF + (size_t)(region - 1) * 65536) + (size_t)kl * 256;
            const float* wr = wo + (size_t)(region == 3 ? 512 : 256) * 1024 + j; const float sc = region == 3 ? 1.f : 0.125f;
#pragma unroll 8
            for (int t = 0; t < 256; ++t) { const float wv = wr[(size_t)t * 1024];
#pragma unroll
                for (int e = 0; e < 8; ++e) acc[e] += Lm[e * 256 + t] * wv; }
#pragma unroll
            for (int e = 0; e < 8; ++e) acc[e] *= sc;
        } else {
#pragma unroll
            for (int e = 0; e < 8; ++e) acc[e] = wo[(size_t)(768 + kl + e) * 1024 + j];
        }
        uint4 o; o.x = pk2(acc[0], acc[1]); o.y = pk2(acc[2], acc[3]); o.z = pk2(acc[4], acc[5]); o.w = pk2(acc[6], acc[7]);
        *(uint4*)(WOUT + (size_t)j * YK + kk0) = o;
    }
    { const int lane = tid & 63, wv = __builtin_amdgcn_readfirstlane(tid >> 6); float* sh_s = sm + 17000; float* red = sm + 26300;
      const float* MODL = (const float*)(ws + WS_MOD) + (size_t)l * 3 * 9216; float* BIAS = (float*)(ws + WS_BIAS);
      __syncthreads();
      for (int i = tid; i < 9216; i += 512) { const int use = i / 3072, mr = (i / 1024) % 3, k = i & 1023; sh_s[i] = MODL[(size_t)mr * 9216 + (3 * use) * 1024 + k]; }
      __syncthreads();
      for (int it = obx(); it < 209; it += ogd()) {
          int use, n, N, drow; const float* W;
          if (it < 176) { const int mat = it / 44, n0 = (it - mat * 44) * 64; use = (mat >> 1) * 2; N = FH; n = n0 + lane; W = inp(p, mat == 0 ? 7 : mat == 1 ? 8 : mat == 2 ? 10 : 11) + (size_t)l * 1024 * FH;
              drow = 256 * (n >> 7) + 128 * (mat & 1) + (n & 127); }
          else { use = 1; N = 2064; n = (it - 176) * 64 + lane; W = inp(p, 13) + (size_t)l * 1024 * 2064; drow = n; }
          float a0 = 0.f, a1 = 0.f, a2 = 0.f;
          if (n < N) { const float* wp = W + (size_t)(wv * 128) * N + n; const float* s0 = sh_s + use * 3072 + wv * 128;
#pragma unroll 8
              for (int k = 0; k < 128; ++k) { const float x = wp[(size_t)k * N]; a0 += s0[k] * x; a1 += s0[1024 + k] * x; a2 += s0[2048 + k] * x; } }
          red[(wv * 3 + 0) * 64 + lane] = a0; red[(wv * 3 + 1) * 64 + lane] = a1; red[(wv * 3 + 2) * 64 + lane] = a2;
          __syncthreads();
          if (tid < 192 && n < N) { const int r = tid >> 6; float sacc = 0.f;
#pragma unroll
              for (int w8 = 0; w8 < 8; ++w8) sacc += red[(w8 * 3 + r) * 64 + lane];
              BIAS[((size_t)use * 3 + r) * 5632 + drow] = sacc; }
          __syncthreads();
      }
      float* RS1 = (float*)(ws + WS_RS + RS_STRIDE);
      for (int i = obx() * 512 + tid; i < MROWS; i += ogd() * 512) RS1[i] = 0.f; }
    if (l == 0) raw_rows(p);
}

struct EpiUp {
    static constexpr bool PERM = true, AFTER_DRAIN = false; bf16_t* H; const float* rs; const float* bias;
    DEVI void operator()(const f32x4 (&acc)[2][2][4][2], const Unit& u, int wr, int wc, int fr, int fq) const {
        const int row0 = u.pm * 256 + wr * 64 + fr, col0 = u.pn * 128 + wc * 32 + 8 * fq; const int mr = u.pm < 64 ? 0 : (u.pm < 128 ? 1 : 2);
        const float* bp = bias + (size_t)mr * 5632 + u.pn * 256 + wc * 32 + 8 * fq;
        const f32x4 bg0 = *(const f32x4*)bp, bg1 = *(const f32x4*)(bp + 4), bu0 = *(const f32x4*)(bp + 128), bu1 = *(const f32x4*)(bp + 132);
        float rsl[2][4];
#pragma unroll
        for (int ai = 0; ai < 2; ++ai)
#pragma unroll
            for (int m = 0; m < 4; ++m) rsl[ai][m] = rs[row0 + ai * 128 + m * 16];
#pragma unroll
        for (int ai = 0; ai < 2; ++ai)
#pragma unroll
            for (int m = 0; m < 4; ++m) { const int row = row0 + ai * 128 + m * 16; bf16_t* rowp = H + (size_t)row * FH + col0;
                const float rv = rsqrtf(rsl[ai][m] * (1.f / 1024.f) + EPS);
                const f32x4 g0 = acc[ai][0][m][0] * rv + bg0, g1 = acc[ai][0][m][1] * rv + bg1, u0 = acc[ai][1][m][0] * rv + bu0, u1 = acc[ai][1][m][1] * rv + bu1;
                u32x4 w; w.x = pk2(siluf(g0[0]) * u0[0], siluf(g0[1]) * u0[1]); w.y = pk2(siluf(g0[2]) * u0[2], siluf(g0[3]) * u0[3]);
                w.z = pk2(siluf(g1[0]) * u1[0], siluf(g1[1]) * u1[1]); w.w = pk2(siluf(g1[2]) * u1[2], siluf(g1[3]) * u1[3]);
                *(u32x4*)rowp = w; }
    }
};
struct EpiRes {
    static constexpr bool PERM = true, AFTER_DRAIN = false; float* outx; float* ctxr; const float* inx; const float* gate; bf16_t* nyraw; float* rsacc; const float* nw; const float* nscale; float mult; int feeds;
    DEVI void operator()(const f32x4 (&acc)[2][2][4][2], const Unit& u, int wr, int wc, int fr, int fq) const {
        const int row0 = u.pm * 256 + wr * 64 + fr, col0 = u.pn * 256 + wc * 32 + 8 * fq; const int mr = u.pm < 64 ? 0 : (u.pm < 128 ? 1 : 2);
        float* base = (u.pm < 128 ? outx + (size_t)row0 * D : ctxr + (size_t)(row0 - T) * D) + col0;
        const float* rbase = (u.pm < 128 ? inx + (size_t)row0 * D : ctxr + (size_t)(row0 - T) * D) + col0;
        f32x4 gv[2][2], cw[2][2];
#pragma unroll
        for (int bj = 0; bj < 2; ++bj)
#pragma unroll
            for (int n = 0; n < 2; ++n) { gv[bj][n] = *(const f32x4*)(gate + (size_t)mr * 9216 + col0 + bj * 128 + n * 4) * mult;
                cw[bj][n] = *(const f32x4*)(nw + col0 + bj * 128 + n * 4) * (*(const f32x4*)(nscale + (size_t)mr * 9216 + col0 + bj * 128 + n * 4) + 1.f); }
        f32x4 rq[2][2][2];
#pragma unroll
        for (int k0 = 0; k0 < 1; ++k0) { const float* rr = rbase + (size_t)((k0 >> 2) * 128 + (k0 & 3) * 16) * D;
#pragma unroll
            for (int bj = 0; bj < 2; ++bj) { rq[k0][bj][0] = *(const f32x4*)(rr + bj * 128); rq[k0][bj][1] = *(const f32x4*)(rr + bj * 128 + 4); } }
#pragma unroll
        for (int k = 0; k < 8; ++k) { const int ai = k >> 2, m = k & 3; float* rowp = base + (size_t)(ai * 128 + m * 16) * D; const int row = row0 + ai * 128 + m * 16; float ss = 0.f;
            if (k + 1 < 8) { const float* rr = rbase + (size_t)(((k + 1) >> 2) * 128 + ((k + 1) & 3) * 16) * D;
#pragma unroll
                for (int bj = 0; bj < 2; ++bj) { rq[(k + 1) & 1][bj][0] = *(const f32x4*)(rr + bj * 128); rq[(k + 1) & 1][bj][1] = *(const f32x4*)(rr + bj * 128 + 4); } }
#pragma unroll
            for (int bj = 0; bj < 2; ++bj) { f32x4* pp = (f32x4*)(rowp + bj * 128);
                const f32x4 n0 = rq[k & 1][bj][0] + gv[bj][0] * acc[ai][bj][m][0], n1 = rq[k & 1][bj][1] + gv[bj][1] * acc[ai][bj][m][1]; pp[0] = n0; pp[1] = n1;
                if (feeds) { const f32x4 y0 = n0 * cw[bj][0], y1 = n1 * cw[bj][1]; u32x4 o; o.x = pk2(y0[0], y0[1]); o.y = pk2(y0[2], y0[3]); o.z = pk2(y1[0], y1[1]); o.w = pk2(y1[2], y1[3]);
                    *(u32x4*)(nyraw + (size_t)row * 1024 + col0 + bj * 128) = o;
                    ss += n0[0] * n0[0] + n0[1] * n0[1] + n0[2] * n0[2] + n0[3] * n0[3] + n1[0] * n1[0] + n1[1] * n1[1] + n1[2] * n1[2] + n1[3] * n1[3]; } }
            if (feeds) { ss += __shfl_xor(ss, 16); ss += __shfl_xor(ss, 32); if (fq == 0) atomicAdd(rsacc + row, ss); } }
    }
};
struct EpiP {
    static constexpr bool PERM = true, AFTER_DRAIN = false; bf16_t* P; const float* rs; const float* bias;
    DEVI void operator()(const f32x4 (&acc)[2][2][4][2], const Unit& u, int wr, int wc, int fr, int fq) const {
        const int row0 = u.pm * 256 + wr * 64 + fr, col0 = u.pn * 256 + wc * 32 + 8 * fq; const int mr = u.pm < 64 ? 0 : (u.pm < 128 ? 1 : 2);
        const float* bp = bias + (size_t)mr * 5632 + col0;
        f32x4 b0[2], b1[2];
#pragma unroll
        for (int bj = 0; bj < 2; ++bj) { b0[bj] = *(const f32x4*)(bp + bj * 128); b1[bj] = *(const f32x4*)(bp + bj * 128 + 4); }
        float rsl[2][4];
#pragma unroll
        for (int ai = 0; ai < 2; ++ai)
#pragma unroll
            for (int m = 0; m < 4; ++m) rsl[ai][m] = rs[row0 + ai * 128 + m * 16];
#pragma unroll
        for (int ai = 0; ai < 2; ++ai)
#pragma unroll
            for (int m = 0; m < 4; ++m) { const int row = row0 + ai * 128 + m * 16; bf16_t* rowp = P + (size_t)row * PPITCH + col0;
                const float rv = rsqrtf(rsl[ai][m] * (1.f / 1024.f) + EPS);
#pragma unroll
                for (int bj = 0; bj < 2; ++bj) if (col0 + bj * 128 < 2064) { const f32x4 v0 = acc[ai][bj][m][0] * rv + b0[bj], v1 = acc[ai][bj][m][1] * rv + b1[bj];
                    u32x4 w; w.x = pk2(v0[0], v0[1]); w.y = pk2(v0[2], v0[3]); w.z = pk2(v1[0], v1[1]); w.w = pk2(v1[2], v1[3]);
                    *(u32x4*)(rowp + bj * 128) = w; } }
    }
};

DEVI f32x4 mini_dot(const bf16_t* arow, const bf16_t* wrow, int K) {
    f32x4 c0 = (f32x4){0.f, 0.f, 0.f, 0.f}, c1 = c0;
#pragma unroll 1
    for (int k = 0; k < K; k += 256) {
        pg8::bf16x8 a[8], w[8];
#pragma unroll
        for (int q = 0; q < 8; ++q) { a[q] = *(const pg8::bf16x8*)(arow + k + 32 * q); w[q] = *(const pg8::bf16x8*)(wrow + k + 32 * q); }
#pragma unroll
        for (int q = 0; q < 8; q += 2) { c0 = __builtin_amdgcn_mfma_f32_16x16x32_bf16(w[q], a[q], c0, 0, 0, 0); c1 = __builtin_amdgcn_mfma_f32_16x16x32_bf16(w[q + 1], a[q + 1], c1, 0, 0, 0); }
    }
    return c0 + c1;
}
DEVI void mini_dot2(const bf16_t* arow, const bf16_t* w0row, const bf16_t* w1row, int K, f32x4& r0, f32x4& r1) {
    f32x4 c0 = (f32x4){0.f, 0.f, 0.f, 0.f}, c1 = c0;
#pragma unroll 1
    for (int k = 0; k < K; k += 256) {
        pg8::bf16x8 a[8], w[8], v[8];
#pragma unroll
        for (int q = 0; q < 8; ++q) { a[q] = *(const pg8::bf16x8*)(arow + k + 32 * q); w[q] = *(const pg8::bf16x8*)(w0row + k + 32 * q); v[q] = *(const pg8::bf16x8*)(w1row + k + 32 * q); }
#pragma unroll
        for (int q = 0; q < 8; ++q) { c0 = __builtin_amdgcn_mfma_f32_16x16x32_bf16(w[q], a[q], c0, 0, 0, 0); c1 = __builtin_amdgcn_mfma_f32_16x16x32_bf16(v[q], a[q], c1, 0, 0, 0); }
    }
    r0 = c0; r1 = c1;
}
DEVI void mini_up(const Params& p, const bf16_t* Wup) { unsigned char* const ws = opq(p.ws);
    const int tid = otid(), lane = tid & 63, fr = lane & 15, fq = lane >> 4;
    const bf16_t* NYp = (const bf16_t*)(ws + WS_NY); bf16_t* H = (bf16_t*)(ws + WS_H);
    for (int id = obx() * 8 + (tid >> 6); id < 32 * 176; id += ogd() * 8) {
        const int rt = id / 176, h0 = (id - rt * 176) * 16, g0 = 256 * (h0 >> 7) + (h0 & 127);
        const bf16_t* arow = NYp + (size_t)(T + 16 * rt + fr) * 1024 + fq * 8;
        f32x4 g, u; mini_dot2(arow, Wup + (size_t)(g0 + fr) * 1024 + fq * 8, Wup + (size_t)(g0 + 128 + fr) * 1024 + fq * 8, 1024, g, u);
        uint2 o; o.x = pk2(siluf(g[0]) * u[0], siluf(g[1]) * u[1]); o.y = pk2(siluf(g[2]) * u[2], siluf(g[3]) * u[3]);
        *(uint2*)(H + (size_t)(T + 16 * rt + fr) * FH + h0 + 4 * fq) = o;
    }
}
DEVI void mini_res(const Params& p, const bf16_t* A, const bf16_t* W, int K, const float* gate, float mult, bf16_t* nyraw, float* rsacc, const float* nw, const float* nscale, const float* Rin, float* sm) { unsigned char* const ws = opq(p.ws);
    const int tid = otid(), lane = tid & 63, wv = tid >> 6, fr = lane & 15, fq = lane >> 4;
    float* R = (float*)(ws + WS_CTXR);
    const int nsteps = K >> 8, kw = (K >> 3) * wv;
    for (int id = obx(); id < 32 * 8; id += ogd()) {
        const int rt = id >> 3, cg = id & 7;
        const bf16_t* arow = A + (size_t)(T + 16 * rt + fr) * K + kw + fq * 8; const bf16_t* wrow = W + (size_t)(128 * cg + fr) * K + kw + fq * 8;
        f32x4 acc[8];
#pragma unroll
        for (int t = 0; t < 8; ++t) acc[t] = (f32x4){0.f, 0.f, 0.f, 0.f};
#pragma unroll 1
        for (int s0 = 0; s0 < nsteps; s0 += 4) {
            pg8::bf16x8 av[4], wf[4][8];
#pragma unroll
            for (int j = 0; j < 4; ++j) { const int o = ((s0 + j) < nsteps ? (s0 + j) : nsteps - 1) * 32; av[j] = *(const pg8::bf16x8*)(arow + o);
#pragma unroll
                for (int t = 0; t < 8; ++t) wf[j][t] = *(const pg8::bf16x8*)(wrow + (size_t)(16 * t) * K + o); }
#pragma unroll
            for (int j = 0; j < 4; ++j) if (s0 + j < nsteps) {
#pragma unroll
                for (int t = 0; t < 8; ++t) acc[t] = __builtin_amdgcn_mfma_f32_16x16x32_bf16(wf[j][t], av[j], acc[t], 0, 0, 0); }
        }
#pragma unroll
        for (int t = 0; t < 8; ++t) *(f32x4*)(sm + ((wv * 8 + t) * 64 + lane) * 4) = acc[t];
        __syncthreads();
        f32x4 tot = (f32x4){0.f, 0.f, 0.f, 0.f};
#pragma unroll
        for (int w8 = 0; w8 < 8; ++w8) tot += *(const f32x4*)(sm + ((w8 * 8 + wv) * 64 + lane) * 4);
        const int row = 16 * rt + fr, col = 128 * cg + 16 * wv + 4 * fq;
        const f32x4 gv = *(const f32x4*)(gate + 2 * 9216 + col) * mult;
        f32x4* pp = (f32x4*)(R + (size_t)row * D + col); const f32x4 nv = *(const f32x4*)(Rin + (size_t)row * D + col) + gv * tot; *pp = nv;
        if (nyraw) { const f32x4 y = nv * (*(const f32x4*)(nw + col) * (*(const f32x4*)(nscale + 2 * 9216 + col) + 1.f));
            uint2 o; o.x = pk2(y[0], y[1]); o.y = pk2(y[2], y[3]); *(uint2*)(nyraw + (size_t)(T + row) * 1024 + col) = o;
            float ss = nv[0] * nv[0] + nv[1] * nv[1] + nv[2] * nv[2] + nv[3] * nv[3]; ss += __shfl_xor(ss, 16); ss += __shfl_xor(ss, 32);
            if (fq == 0) atomicAdd(rsacc + T + row, ss); }
        __syncthreads();
    }
}
DEVI void mini_in(const Params& p) { unsigned char* const ws = opq(p.ws);
    const int tid = otid(), lane = tid & 63, fr = lane & 15, fq = lane >> 4;
    const bf16_t* NYp = (const bf16_t*)(ws + WS_NY); const bf16_t* W = (const bf16_t*)(ws + WS_WIN); bf16_t* P = (bf16_t*)(ws + WS_P);
    for (int id = obx() * 8 + (tid >> 6); id < 32 * 129 + 2048; id += ogd() * 8) {
        int row0, n0;
        if (id < 32 * 129) { const int rt = id / 129; row0 = T + 16 * rt; n0 = (id - rt * 129) * 16; } else { row0 = (id - 32 * 129) * 16; n0 = 2048; }
        const f32x4 acc = mini_dot(NYp + (size_t)(row0 + fr) * 1024 + fq * 8, W + (size_t)(n0 + fr) * 1024 + fq * 8, 1024);
        uint2 o; o.x = pk2(acc[0], acc[1]); o.y = pk2(acc[2], acc[3]);
        *(uint2*)(P + (size_t)(row0 + fr) * PPITCH + n0 + 4 * fq) = o;
    }
}

DEVI float dpp_xor1(float v) { return __int_as_float(__builtin_amdgcn_update_dpp(0, __float_as_int(v), 0xB1, 0xF, 0xF, true)); }
DEVI float dpp_xor2(float v) { return __int_as_float(__builtin_amdgcn_update_dpp(0, __float_as_int(v), 0x4E, 0xF, 0xF, true)); }
constexpr int CW_OFF = 28672;
struct G1Raw { uint4 v0[3], v1[3], v2[3]; unsigned ab; };
DEVI void g1_decode(int item, int tid, int& chain, int& ci, int& dir, int& h, int& seqbase, int& len, int& jj) {
    chain = item / NCH; ci = item - chain * NCH;
    const int b = chain >> 3; dir = (chain >> 2) & 1; h = chain & 3;
    int j, nc;
    if (ci < 4) { seqbase = T + b * 256; len = 256; j = ci; nc = 4; } else { seqbase = b * SEQ; len = SEQ; j = ci - 4; nc = 256; }
    jj = dir ? nc - 1 - j : j;
}
DEVI void g1_load(const Params& p, int item, G1Raw& raw) { unsigned char* const ws = opq(p.ws);
    const int tid = otid(); int chain, ci, dir, h, seqbase, len, jj; g1_decode(item, tid, chain, ci, dir, h, seqbase, len, jj);
    const bf16_t* P = (const bf16_t*)(ws + WS_P);
    const int r = tid >> 3, d8 = (tid & 7) * 8;
    const int pos = dir ? 64 * jj + 63 - r : 64 * jj + r, posL = pos > 0 ? pos - 1 : 0, posR = pos < len - 1 ? pos + 1 : len - 1;
    const bf16_t* pr = P + (size_t)(seqbase + pos) * PPITCH; const bf16_t* pl = P + (size_t)(seqbase + posL) * PPITCH; const bf16_t* pq = P + (size_t)(seqbase + posR) * PPITCH;
#pragma unroll
    for (int w3 = 0; w3 < 3; ++w3) { const int cb = 1024 + w3 * 256 + h * 64 + d8;
        raw.v1[w3] = *(const uint4*)(pr + cb); raw.v0[w3] = *(const uint4*)(pl + cb); raw.v2[w3] = *(const uint4*)(pq + cb); }
    const int hd = dir * 4 + h;
    raw.ab = (unsigned)pr[2048 + hd] | ((unsigned)pr[2056 + hd] << 16);
}
DEVI void g1_item(const Params& p, int l, int item, int next_item, G1Raw& raw, float* sm) { unsigned char* const ws = opq(p.ws);
    const int tid = otid(), lane = tid & 63, wv = tid >> 6;
    int chain, ci, dir, h, seqbase, len, jj; g1_decode(item, tid, chain, ci, dir, h, seqbase, len, jj);
    bf16_t* q_b = (bf16_t*)sm; bf16_t* k_b = q_b + 4608; bf16_t* kdT_b = q_b + 9216; bf16_t* aqk_b = q_b + 13824; bf16_t* XT_b = q_b + 18432;
    float* Mp = sm + 13824;
    float* X_s = sm + 18176;
    float* gc_s = sm + 26624; float* be_s = gc_s + 64; float* eg_s = gc_s + 128; float* kd_s = gc_s + 192; float* gt_s = gc_s + 256; float* misc = gc_s + 320;
    float kf[8];
    {
        const int r = tid >> 3, d8 = (tid & 7) * 8;
        const int pos = dir ? 64 * jj + 63 - r : 64 * jj + r;
        const bool hasL = pos > 0, hasR = pos < len - 1;
        const float* cw = sm + CW_OFF;
        float val[3][8];
#pragma unroll
        for (int w3 = 0; w3 < 3; ++w3) {
            const int cb = w3 * 256 + h * 64 + d8;
            const uint4 z = make_uint4(0u, 0u, 0u, 0u);
            const uint4 v1 = raw.v1[w3];
            const uint4 v0 = hasL ? raw.v0[w3] : z;
            const uint4 v2 = hasR ? raw.v2[w3] : z;
            float x0[8], x1[8], x2[8]; UNPACK8(v0, x0); UNPACK8(v1, x1); UNPACK8(v2, x2);
#pragma unroll
            for (int e = 0; e < 8; ++e) val[w3][e] = siluf(x0[e] * cw[cb + e] + x1[e] * cw[768 + cb + e] + x2[e] * cw[1536 + cb + e]);
        }
        const unsigned ab = raw.ab;
        if (next_item >= 0) g1_load(p, next_item, raw);
        float sq = 0.f, sk = 0.f;
#pragma unroll
        for (int e = 0; e < 8; ++e) { sq += val[0][e] * val[0][e]; sk += val[1][e] * val[1][e]; }
        sq += __shfl_xor(sq, 1); sq += __shfl_xor(sq, 2); sq += __shfl_xor(sq, 4);
        sk += __shfl_xor(sk, 1); sk += __shfl_xor(sk, 2); sk += __shfl_xor(sk, 4);
        const float qs = rsqrtf(sq + EPS) * 0.125f, ks = rsqrtf(sk + EPS);
        const int hd = dir * 4 + h;
        const float av = __uint_as_float(ab << 16), bv = __uint_as_float(ab & 0xFFFF0000u);
        const float beta = sigmf(bv);
        const float xa = av + inp(p, 25)[l * 8 + hd];
        const float sp = xa > 20.f ? xa : log1pf(__expf(xa));
        const float g = -__expf(inp(p, 24)[l * 8 + hd]) * sp;
#pragma unroll
        for (int e = 0; e < 8; ++e) kf[e] = val[1][e] * ks;
        uint4 o; o.x = pk2(val[0][0] * qs, val[0][1] * qs); o.y = pk2(val[0][2] * qs, val[0][3] * qs); o.z = pk2(val[0][4] * qs, val[0][5] * qs); o.w = pk2(val[0][6] * qs, val[0][7] * qs);
        *(uint4*)(q_b + r * 72 + d8) = o;
        o.x = pk2(kf[0], kf[1]); o.y = pk2(kf[2], kf[3]); o.z = pk2(kf[4], kf[5]); o.w = pk2(kf[6], kf[7]);
        *(uint4*)(k_b + r * 72 + d8) = o;
        *(float4*)(X_s + r * 132 + d8) = make_float4(val[2][0] * beta, val[2][1] * beta, val[2][2] * beta, val[2][3] * beta);
        *(float4*)(X_s + r * 132 + d8 + 4) = make_float4(val[2][4] * beta, val[2][5] * beta, val[2][6] * beta, val[2][7] * beta);
        if ((tid & 7) == 0) { gt_s[r] = g; be_s[r] = beta; }
    }
    __syncthreads();
    { float v = gt_s[lane];
#pragma unroll
        for (int o = 1; o < 64; o <<= 1) { const float t = __shfl_up(v, o); if (lane >= o) v += t; }
        const float gl = __shfl(v, 63); gc_s[lane] = v; eg_s[lane] = __expf(v); kd_s[lane] = __expf(gl - v); if (lane == 63) misc[0] = __expf(gl); }
    { const int r = tid >> 3, d8 = (tid & 7) * 8; const float f = be_s[r] * eg_s[r], kdr = kd_s[r];
        *(float4*)(X_s + r * 132 + 64 + d8) = make_float4(kf[0] * f, kf[1] * f, kf[2] * f, kf[3] * f);
        *(float4*)(X_s + r * 132 + 64 + d8 + 4) = make_float4(kf[4] * f, kf[5] * f, kf[6] * f, kf[7] * f);
#pragma unroll
        for (int e = 0; e < 8; ++e) kdT_b[(d8 + e) * 72 + ((((r >> 3) ^ (tid & 7)) << 3) | (r & 7))] = f2bf(kf[e] * kdr); }
    {
        const int isQ = wv >> 2, ti = wv & 3, fr = lane & 15, fq = lane >> 4;
        const bf16_t* Lb = isQ ? q_b : k_b;
        const pg8::bf16x8 a0 = *(const pg8::bf16x8*)(Lb + (16 * ti + fr) * 72 + fq * 8), a1 = *(const pg8::bf16x8*)(Lb + (16 * ti + fr) * 72 + fq * 8 + 32);
        for (int tj = 0; tj < 4; ++tj) {
            f32x4 acc = (f32x4){0.f, 0.f, 0.f, 0.f};
            if (tj <= ti) {
                const pg8::bf16x8 b0 = *(const pg8::bf16x8*)(k_b + (16 * tj + fr) * 72 + fq * 8), b1 = *(const pg8::bf16x8*)(k_b + (16 * tj + fr) * 72 + fq * 8 + 32);
                acc = __builtin_amdgcn_mfma_f32_16x16x32_bf16(a0, b0, acc, 0, 0, 0);
                acc = __builtin_amdgcn_mfma_f32_16x16x32_bf16(a1, b1, acc, 0, 0, 0);
            }
            const int jn = 16 * tj + fr; const float gj = gc_s[jn];
#pragma unroll
            for (int rg = 0; rg < 4; ++rg) { const int i = 16 * ti + fq * 4 + rg;
                const float dec = i >= jn ? __expf(gc_s[i] - gj) : 0.f;
                if (!isQ) { if (tj <= ti) Mp[i * 68 + (jn & 3) * 16 + (jn >> 2)] = (i > jn) ? be_s[i] * acc[rg] * dec : 0.f; }
                else aqk_b[i * 72 + jn] = (i >= jn) ? f2bf(acc[rg] * dec) : (bf16_t)0; }
        }
    }
    float* Td = gc_s + 384;
    if (wv < 4) {
        const int I = wv, cq = lane >> 2, pp = lane & 3;
        float xr[4] = {0.f, 0.f, 0.f, 0.f}, mb[16][4];
#pragma unroll
        for (int r = 0; r < 16; ++r) { const float4 m4 = *(const float4*)(Mp + (16 * I + r) * 68 + pp * 16 + 4 * I); mb[r][0] = m4.x; mb[r][1] = m4.y; mb[r][2] = m4.z; mb[r][3] = m4.w; }
#pragma unroll
        for (int r = 0; r < 16; ++r) { float part = 0.f;
#pragma unroll
            for (int q = 0; q < (r + 3) / 4; ++q) part += mb[r][q] * xr[q];
            part += dpp_xor1(part); part += dpp_xor2(part);
            const float ti = (r == cq ? 1.f : 0.f) - part;
            if (pp == (r & 3)) xr[r >> 2] = ti; }
#pragma unroll
        for (int q = 0; q < 4; ++q) Td[I * 256 + (4 * q + pp) * 16 + cq] = xr[q];
    }
    __syncthreads();
    {
        const int fr = lane & 15, fq = lane >> 4, c = 16 * wv + fr;
        f32x4 R[4];
#pragma unroll
        for (int I = 0; I < 4; ++I)
#pragma unroll
            for (int rg = 0; rg < 4; ++rg) R[I][rg] = X_s[(16 * I + 4 * fq + rg) * 132 + c];
#pragma unroll
        for (int I = 0; I < 4; ++I) {
            f32x4 x = (f32x4){0.f, 0.f, 0.f, 0.f};
#pragma unroll
            for (int kk = 0; kk < 4; ++kk) x = __builtin_amdgcn_mfma_f32_16x16x4f32(Td[I * 256 + fr * 16 + 4 * fq + kk], R[I][kk], x, 0, 0, 0);
#pragma unroll
            for (int I2 = I + 1; I2 < 4; ++I2)
#pragma unroll
                for (int kk = 0; kk < 4; ++kk) R[I2] = __builtin_amdgcn_mfma_f32_16x16x4f32(-Mp[(16 * I2 + fr) * 68 + kk * 16 + 4 * I + fq], x[kk], R[I2], 0, 0, 0);
            uint2 o; o.x = pk2(x[0], x[1]); o.y = pk2(x[2], x[3]);
            *(uint2*)(XT_b + c * 72 + 16 * I + 4 * fq) = o;
        }
    }
    __syncthreads();
    {
        const int fr = lane & 15, fq = lane >> 4, c = 16 * wv + fr;
        const pg8::bf16x8 b0 = *(const pg8::bf16x8*)(XT_b + c * 72 + fq * 8), b1 = *(const pg8::bf16x8*)(XT_b + c * 72 + fq * 8 + 32);
        const float egl = misc[0];
        float* rec = (float*)(ws + WS_GD) + (size_t)(chain * NCH + ci) * GD_REC_F;
        bf16_t* Qp = (bf16_t*)(rec + 8192); bf16_t* Op = Qp + 4096;
#pragma unroll
        for (int rt = 0; rt < 4; ++rt) {
            const int kg = (2 * rt + (fr >> 3)) & 7;
            const pg8::bf16x8 k0 = *(const pg8::bf16x8*)(kdT_b + (16 * rt + fr) * 72 + ((fq ^ kg) << 3)), k1 = *(const pg8::bf16x8*)(kdT_b + (16 * rt + fr) * 72 + (((fq + 4) ^ kg) << 3));
            const pg8::bf16x8 q0 = *(const pg8::bf16x8*)(aqk_b + (16 * rt + fr) * 72 + fq * 8), q1 = *(const pg8::bf16x8*)(aqk_b + (16 * rt + fr) * 72 + fq * 8 + 32);
            f32x4 a1 = (f32x4){0.f, 0.f, 0.f, 0.f}, a2 = (f32x4){0.f, 0.f, 0.f, 0.f};
            a1 = __builtin_amdgcn_mfma_f32_16x16x32_bf16(k0, b0, a1, 0, 0, 0); a1 = __builtin_amdgcn_mfma_f32_16x16x32_bf16(k1, b1, a1, 0, 0, 0);
            a2 = __builtin_amdgcn_mfma_f32_16x16x32_bf16(q0, b0, a2, 0, 0, 0); a2 = __builtin_amdgcn_mfma_f32_16x16x32_bf16(q1, b1, a2, 0, 0, 0);
            if (wv < 4) *(f32x4*)(rec + 4096 + ((wv * 4 + rt) * 64 + lane) * 4) = a1;
#pragma unroll
            for (int rg = 0; rg < 4; ++rg) { const int d1 = 16 * rt + fq * 4 + rg;
                if (wv < 4) { Op[d1 * 64 + c] = f2bf(a2[rg]); }
                else { const int cc = c - 64; rec[(((d1 >> 4) * 4 + (cc >> 4)) * 64 + (cc & 3) * 16 + (d1 & 15)) * 4 + ((cc >> 2) & 3)] = (d1 == cc ? egl : 0.f) - a1[rg]; Qp[d1 * 64 + cc] = f2bf(bf2f(q_b[d1 * 72 + cc]) * eg_s[d1] - a2[rg]); } }
        }
    }
    __syncthreads();
}

template <int LOGN, int LOGCH>
DEVI void fft_lds(float2* X, const float2* tw) {
    const int tid = otid(); constexpr int CH = 1 << LOGCH;
#pragma unroll 1
    for (int s = 1; s <= LOGN; ++s) {
        const int half = 1 << (s - 1);
#pragma unroll
        for (int i = 0; i < 8; ++i) {
            const int bi = tid + 512 * i, ch = bi & (CH - 1), bf = bi >> LOGCH;
            const int jx = bf & (half - 1), grp = bf >> (s - 1);
            const int i0 = (grp << s) + jx, i1 = i0 + half;
            const float2 w = tw[jx << (LOGN - s)];
            const float2 a = X[i0 * CH + ch], bq = X[i1 * CH + ch];
            const float2 t = make_float2(w.x * bq.x - w.y * bq.y, w.x * bq.y + w.y * bq.x);
            X[i0 * CH + ch] = make_float2(a.x + t.x, a.y + t.y); X[i1 * CH + ch] = make_float2(a.x - t.x, a.y - t.y);
        }
        __syncthreads();
    }
}
DEVI void fft128_lds(float2* X, const float2* tw) { fft_lds<7, 6>(X, tw); }
DEVI void trig_tables(float* sm) {
    const int tid = otid();
    if (tid < 64) { float s, c; sincospif((float)tid * (1.f / 64.f), &s, &c); ((float2*)(sm + TAB_OFF))[tid] = make_float2(c, -s); }
    if (tid < 128) { float s, c; sincospif((float)tid * (1.f / 128.f), &s, &c); ((float2*)(sm + TAB_OFF + 128))[tid] = make_float2(c, -s); }
    __syncthreads();
}
DEVI void fft1_item(const Params& p, int item, float* sm) { unsigned char* const ws = opq(p.ws);
    const int tid = otid(); const int cb = item & 3, bb = (item >> 2) & 127, b = item >> 9;
    const bf16_t* P = (const bf16_t*)(ws + WS_P); float2* X = (float2*)sm; const float2* tw = (const float2*)(sm + TAB_OFF);
#pragma unroll
    for (int i = 0; i < 2; ++i) { const int ti = tid + 512 * i, a = ti >> 3, c8 = ti & 7;
        const uint4 v = *(const uint4*)(P + (size_t)(b * SEQ + 128 * a + bb) * PPITCH + 256 + cb * 64 + c8 * 8);
        float f[8]; UNPACK8(v, f); const int ra = (int)(__brev((unsigned)a) >> 25);
#pragma unroll
        for (int e = 0; e < 8; ++e) X[ra * 64 + c8 * 8 + e] = make_float2(f[e], 0.f); }
    __syncthreads();
    fft128_lds(X, tw);
    float2* FS = (float2*)(ws + WS_FS);
    float s, co, ss, cs; sincospif((float)(bb * (tid >> 6)) * (-2.f / 16384.f), &s, &co); sincospif((float)(bb * 8) * (-2.f / 16384.f), &ss, &cs);
#pragma unroll 4
    for (int i = 0; i < 16; ++i) { const int ti = tid + 512 * i, ch = ti & 63, c = ti >> 6;
        const float2 v = X[c * 64 + ch];
        FS[((size_t)(b * 128 + c) * 128 + bb) * 256 + cb * 64 + ch] = make_float2(v.x * co - v.y * s, v.x * s + v.y * co);
        const float nc = co * cs - s * ss, ns = co * ss + s * cs; co = nc; s = ns; }
    __syncthreads();
}
DEVI void fft2_item(const Params& p, int item, float* sm) { unsigned char* const ws = opq(p.ws);
    const int tid = otid(); const int cb = item & 3, c = (item >> 2) & 127, b = item >> 9;
    float2* X = (float2*)sm; const float2* tw = (const float2*)(sm + TAB_OFF);
    const float2* FS = (const float2*)(ws + WS_FS) + (size_t)(b * 128 + c) * 128 * 256 + cb * 64;
#pragma unroll 4
    for (int i = 0; i < 16; ++i) { const int ti = tid + 512 * i, ch = ti & 63, bb = ti >> 6;
        X[(int)(__brev((unsigned)bb) >> 25) * 64 + ch] = FS[(size_t)bb * 256 + ch]; }
    __syncthreads();
    fft128_lds(X, tw);
    bf16_t* Y = (bf16_t*)(ws + WS_NY);
#pragma unroll
    for (int i = 0; i < 2; ++i) { const int ti = tid + 512 * i, d = ti >> 3, c8 = ti & 7;
        float re[8], im[8];
#pragma unroll
        for (int e = 0; e < 8; ++e) { const float2 v = X[d * 64 + c8 * 8 + e]; re[e] = v.x * (1.f / 128.f); im[e] = v.y * (1.f / 128.f); }
        bf16_t* yr = Y + (size_t)(b * SEQ + c + 128 * d) * YK + 256 + cb * 64 + c8 * 8;
        uint4 o; o.x = pk2(re[0], re[1]); o.y = pk2(re[2], re[3]); o.z = pk2(re[4], re[5]); o.w = pk2(re[6], re[7]); *(uint4*)yr = o;
        o.x = pk2(im[0], im[1]); o.y = pk2(im[2], im[3]); o.z = pk2(im[4], im[5]); o.w = pk2(im[6], im[7]); *(uint4*)(yr + 256) = o; }
    __syncthreads();
}
DEVI void ctxfft_item(const Params& p, int item, float* sm) { unsigned char* const ws = opq(p.ws);
    const int tid = otid(); const int cb = item & 7, b = item >> 3;
    const bf16_t* P = (const bf16_t*)(ws + WS_P); float2* X = (float2*)sm; const float2* tw = (const float2*)(sm + TAB_OFF + 128);
#pragma unroll
    for (int i = 0; i < 2; ++i) { const int ti = tid + 512 * i, n = ti >> 2, c8 = ti & 3;
        const uint4 v = *(const uint4*)(P + (size_t)(T + b * 256 + n) * PPITCH + 256 + cb * 32 + c8 * 8);
        float f[8]; UNPACK8(v, f); const int rn = (int)(__brev((unsigned)n) >> 24);
#pragma unroll
        for (int e = 0; e < 8; ++e) X[rn * 32 + c8 * 8 + e] = make_float2(f[e], 0.f); }
    __syncthreads();
    fft_lds<8, 5>(X, tw);
    bf16_t* Y = (bf16_t*)(ws + WS_NY);
#pragma unroll
    for (int i = 0; i < 2; ++i) { const int ti = tid + 512 * i, k = ti >> 2, c8 = ti & 3;
        float re[8], im[8];
#pragma unroll
        for (int e = 0; e < 8; ++e) { const float2 v = X[k * 32 + c8 * 8 + e]; re[e] = v.x * (1.f / 16.f); im[e] = v.y * (1.f / 16.f); }
        bf16_t* yr = Y + (size_t)(T + b * 256 + k) * YK + 256 + cb * 32 + c8 * 8;
        uint4 o; o.x = pk2(re[0], re[1]); o.y = pk2(re[2], re[3]); o.z = pk2(re[4], re[5]); o.w = pk2(re[6], re[7]); *(uint4*)yr = o;
        o.x = pk2(im[0], im[1]); o.y = pk2(im[2], im[3]); o.z = pk2(im[4], im[5]); o.w = pk2(im[6], im[7]); *(uint4*)(yr + 256) = o; }
    __syncthreads();
}
DEVI void conv_item(const Params& p, int l, int item, float* sm) { unsigned char* const ws = opq(p.ws);
    const int tid = otid(), lane = tid & 63, wv = tid >> 6;
    int base, len, tile;
    if (item < 1024) { base = (item >> 9) * SEQ; len = SEQ; tile = item & 511; } else { const int cj = item - 1024; base = T + (cj >> 3) * 256; len = 256; tile = cj & 7; }
    const int t0 = tile * 32;
    const bf16_t* P = (const bf16_t*)(ws + WS_P);
    float* glu = sm;
    float* hb = sm + 62 * 256;
    for (int ti = tid; ti < 62 * 32; ti += 512) { const int pp = ti >> 5, c8 = ti & 31, pos = t0 - 15 + pp;
        float o[8];
        if (pos >= 0 && pos < len) { const bf16_t* pr = P + (size_t)(base + pos) * PPITCH + 512 + c8 * 8;
            const uint4 va = *(const uint4*)pr, vb = *(const uint4*)(pr + 256); float fa[8], fb[8]; UNPACK8(va, fa); UNPACK8(vb, fb);
#pragma unroll
            for (int e = 0; e < 8; ++e) o[e] = fa[e] * sigmf(fb[e]);
        } else {
#pragma unroll
            for (int e = 0; e < 8; ++e) o[e] = 0.f; }
        *(float4*)(glu + pp * 256 + c8 * 8) = make_float4(o[0], o[1], o[2], o[3]); *(float4*)(glu + pp * 256 + c8 * 8 + 4) = make_float4(o[4], o[5], o[6], o[7]); }
    __syncthreads();
    { const int ch = tid & 255, half = tid >> 8; const float* w = inp(p, 18) + (size_t)l * 31 * 256 + ch; const float bias = inp(p, 19)[l * 256 + ch];
        float wr[31];
#pragma unroll
        for (int jx = 0; jx < 31; ++jx) wr[jx] = w[jx * 256];
        float win[46];
#pragma unroll
        for (int jx = 0; jx < 46; ++jx) win[jx] = glu[(half * 16 + jx) * 256 + ch];
#pragma unroll
        for (int pi = 0; pi < 16; ++pi) { float h = bias;
#pragma unroll
            for (int jx = 0; jx < 31; ++jx) h += win[pi + jx] * wr[jx];
            hb[(half * 16 + pi) * 256 + ch] = h; } }
    __syncthreads();
    { const float4 g4 = *(const float4*)(inp(p, 20) + l * 256 + lane * 4), b4 = *(const float4*)(inp(p, 21) + l * 256 + lane * 4);
        bf16_t* Y = (bf16_t*)(ws + WS_NY);
#pragma unroll
        for (int qi = 0; qi < 4; ++qi) { const int q = wv * 4 + qi; const float4 h4 = *(const float4*)(hb + q * 256 + lane * 4);
            const float mu = wave_sum(h4.x + h4.y + h4.z + h4.w) * (1.f / 256.f);
            const float dx = h4.x - mu, dy = h4.y - mu, dz = h4.z - mu, dw = h4.w - mu;
            const float var = wave_sum(dx * dx + dy * dy + dz * dz + dw * dw) * (1.f / 256.f); const float rs = rsqrtf(var + EPS);
            uint2 o; o.x = pk2(siluf(dx * rs * g4.x + b4.x), siluf(dy * rs * g4.y + b4.y)); o.y = pk2(siluf(dz * rs * g4.z + b4.z), siluf(dw * rs * g4.w + b4.w));
            *(uint2*)(Y + (size_t)(base + t0 + q) * YK + 768 + lane * 4) = o; } }
    __syncthreads();
}
DEVI void poolx_item(const Params& p, int item, float* sm) { unsigned char* const ws = opq(p.ws);
    const int tid = otid(); const int g = item & 3, r0 = ((item >> 2) & 31) * 8, b = item >> 7, w = 2 << g, hw = w >> 1;
    const int c = tid >> 3, c8 = tid & 7, ch0 = g * 64 + c8 * 8;
    const bf16_t* P = (const bf16_t*)(ws + WS_P) + (size_t)b * SEQ * PPITCH + (size_t)c * PPITCH + ch0;
    bf16_t* Y = (bf16_t*)(ws + WS_NY) + (size_t)b * SEQ * YK + (size_t)c * YK + ch0;
    float* Vs = sm;
#define ADD8(A, B, v, sgn) do { (A).x += (sgn) * __uint_as_float((v).x << 16); (A).y += (sgn) * __uint_as_float((v).x & 0xFFFF0000u); (A).z += (sgn) * __uint_as_float((v).y << 16); (A).w += (sgn) * __uint_as_float((v).y & 0xFFFF0000u); \
        (B).x += (sgn) * __uint_as_float((v).z << 16); (B).y += (sgn) * __uint_as_float((v).z & 0xFFFF0000u); (B).z += (sgn) * __uint_as_float((v).w << 16); (B).w += (sgn) * __uint_as_float((v).w & 0xFFFF0000u); } while (0)
    float4 V0 = make_float4(0.f, 0.f, 0.f, 0.f), V1 = V0;
    { const int lo = max(r0 - hw, 0), hi = min(r0 + w - hw, 256);
#pragma unroll
      for (int rr = 0; rr < 16; ++rr) { const int r = lo + rr; if (r < hi) { const uint4 v = *(const uint4*)(P + (size_t)r * 64 * PPITCH); ADD8(V0, V1, v, 1.f); } } }
    const int c0 = max(c - hw, 0), c1 = min(c + w - hw, 64);
#pragma unroll 1
    for (int i = 0; i < 8; ++i) { const int r = r0 + i, radd = r + w - hw, rsub = r - hw;
        *(float4*)(Vs + c * 64 + c8 * 8) = V0; *(float4*)(Vs + c * 64 + c8 * 8 + 4) = V1;
        const uint4 z = make_uint4(0u, 0u, 0u, 0u);
        uint4 va = *(const uint4*)(P + (size_t)min(radd, 255) * 64 * PPITCH), vs = *(const uint4*)(P + (size_t)max(rsub, 0) * 64 * PPITCH); const uint4 uv = *(const uint4*)(P + (size_t)r * 64 * PPITCH);
        if (radd >= 256) va = z; if (rsub < 0) vs = z;
        __syncthreads();
        float4 s0 = make_float4(0.f, 0.f, 0.f, 0.f), s1 = s0;
        for (int cc = c0; cc < c1; ++cc) { const float4 x = *(const float4*)(Vs + cc * 64 + c8 * 8), y = *(const float4*)(Vs + cc * 64 + c8 * 8 + 4);
            s0.x += x.x; s0.y += x.y; s0.z += x.z; s0.w += x.w; s1.x += y.x; s1.y += y.y; s1.z += y.z; s1.w += y.w; }
        const float inv = 1.f / (float)((min(radd, 256) - max(rsub, 0)) * (c1 - c0));
        float4 u0 = make_float4(0.f, 0.f, 0.f, 0.f), u1 = u0; ADD8(u0, u1, uv, 1.f);
        uint4 o; o.x = pk2(s0.x * inv - u0.x, s0.y * inv - u0.y); o.y = pk2(s0.z * inv - u0.z, s0.w * inv - u0.w); o.z = pk2(s1.x * inv - u1.x, s1.y * inv - u1.y); o.w = pk2(s1.z * inv - u1.z, s1.w * inv - u1.w);
        *(uint4*)(Y + (size_t)r * 64 * YK) = o;
        ADD8(V0, V1, va, 1.f); ADD8(V0, V1, vs, -1.f);
        __syncthreads();
    }
#undef ADD8
}
DEVI void poolc_item(const Params& p, int item) { unsigned char* const ws = opq(p.ws);
    const int tid = otid(); const bf16_t* P = (const bf16_t*)(ws + WS_P); bf16_t* Y = (bf16_t*)(ws + WS_NY);
    const int b = item >> 4, c8 = tid & 31, n = (item & 15) * 16 + (tid >> 5), w = 2 << (c8 >> 3);
    const int lo = max(n - w / 2, 0), hi = min(n + w - w / 2, 256);
    float s[8];
#pragma unroll
    for (int e = 0; e < 8; ++e) s[e] = 0.f;
#pragma unroll
    for (int rr = 0; rr < 16; ++rr) { const int r = lo + rr; if (r < hi) { const uint4 v = *(const uint4*)(P + (size_t)(T + b * 256 + r) * PPITCH + c8 * 8); float f[8]; UNPACK8(v, f);
#pragma unroll
        for (int e = 0; e < 8; ++e) s[e] += f[e]; } }
    const float inv = 1.f / (float)(hi - lo); const size_t row = (size_t)(T + b * 256 + n);
    const uint4 uv = *(const uint4*)(P + row * PPITCH + c8 * 8); float u[8]; UNPACK8(uv, u);
    uint4 o; o.x = pk2(s[0] * inv - u[0], s[1] * inv - u[1]); o.y = pk2(s[2] * inv - u[2], s[3] * inv - u[3]); o.z = pk2(s[4] * inv - u[4], s[5] * inv - u[5]); o.w = pk2(s[6] * inv - u[6], s[7] * inv - u[7]);
    *(uint4*)(Y + row * YK + c8 * 8) = o;
}
#ifndef M2_CONV
#define M2_CONV 0
#define M2_POOL 1
#endif
DEVI void phase_m1(const Params& p, int l, float* sm) {
    trig_tables(sm);
    constexpr int N_G1 = 16 * NCH, N_F1 = 1024, N_CV = 1040, N_PX = 256, N_CF = 16, N_PC = 32;
    const int G = ogd(), bx = obx();
    { const float* cwg = inp(p, 23) + (size_t)l * 3 * 768; for (int i = otid(); i < 2304; i += 512) sm[CW_OFF + i] = cwg[i]; }
    __syncthreads();
    { G1Raw raw; int it = bx; if (it < N_G1) g1_load(p, it, raw);
      for (; it < N_G1; it += G) g1_item(p, l, it, it + G < N_G1 ? it + G : -1, raw, sm); }
    for (int it = (bx + 192) % G; it < N_F1; it += G) fft1_item(p, it, sm);
    if (!M2_CONV) for (int it = (bx + 176) % G; it < N_CV; it += G) conv_item(p, l, it, sm);
    if (!M2_POOL) { for (int it = bx; it < N_PX; it += G) poolx_item(p, it, sm);
        for (int it = (bx + 128) % G; it < N_CF; it += G) ctxfft_item(p, it, sm);
        for (int it = (bx + 96) % G; it < N_PC; it += G) poolc_item(p, it); }
}

DEVI void scan_block(const Params& p, int sb, float* sm) { unsigned char* const ws = opq(p.ws);
    const int tid = otid(), lane = tid & 63, wv = tid >> 6, chain = sb >> 2, slice = sb & 3;
    const int rt = wv & 3, fr = lane & 15, fq = lane >> 4; const bool act = wv < 4;
    float* Sl = sm;
    float* base = (float*)(ws + WS_GD) + (size_t)chain * NCH * GD_REC_F;
    const int aoff = (rt * 4 * 64 + lane) * 4, boff = 4096 + ((slice * 4 + rt) * 64 + lane) * 4;
    float zz = 0.f; asm volatile("" : "+v"(zz));
    f32x4 sreg = (f32x4){zz, zz, zz, zz};
    if (act) {
#pragma unroll
        for (int rg = 0; rg < 4; ++rg) Sl[(16 * rt + 4 * fq + rg) * 16 + fr] = zz; }
    f32x4 a_0[4], a_1[4], a_2[4], a_3[4], a_4[4], a_5[4], a_6[4], a_7[4]; f32x4 b_0, b_1, b_2, b_3, b_4, b_5, b_6, b_7;
    b_0 = b_1 = b_2 = b_3 = b_4 = b_5 = b_6 = b_7 = sreg;
#pragma unroll
    for (int q = 0; q < 4; ++q) a_0[q] = a_1[q] = a_2[q] = a_3[q] = a_4[q] = a_5[q] = a_6[q] = a_7[q] = sreg;
#define SC_LD(st, idx) do { const float* ra_ = base + (size_t)((idx) < NCH ? (idx) : NCH - 1) * GD_REC_F; b_##st = *(const f32x4*)(ra_ + boff); \
        _Pragma("unroll") for (int q = 0; q < 4; ++q) a_##st[q] = *(const f32x4*)(ra_ + aoff + q * 256); } while (0)
#define SC_STEP(st, sn, idx) do { \
        f32x4 c0_ = b_##st, c1_ = (f32x4){0.f, 0.f, 0.f, 0.f}; \
        if (act) { \
            const float* Sc_ = Sl + ((idx) & 1) * 1024; \
            asm volatile("" :: "v"(c0_[0]), "v"(c0_[3]) : "memory"); \
            *(f32x4*)(base + (size_t)(idx) * GD_REC_F + boff) = sreg; \
            _Pragma("unroll") for (int kk = 0; kk < 16; kk += 2) { \
                const float s0_ = Sc_[(4 * kk + fq) * 16 + fr], s1_ = Sc_[(4 * kk + 4 + fq) * 16 + fr]; \
                c0_ = __builtin_amdgcn_mfma_f32_16x16x4f32(a_##st[kk >> 2][kk & 3], s0_, c0_, 0, 0, 0); \
                c1_ = __builtin_amdgcn_mfma_f32_16x16x4f32(a_##st[(kk + 1) >> 2][(kk + 1) & 3], s1_, c1_, 0, 0, 0); } \
        } \
        SC_LD(sn, (idx) + 7); \
        if (act) { float* Sn_ = Sl + (((idx) + 1) & 1) * 1024; sreg = c0_ + c1_; \
            _Pragma("unroll") for (int rg = 0; rg < 4; ++rg) Sn_[(16 * rt + 4 * fq + rg) * 16 + fr] = sreg[rg]; } \
        __syncthreads(); } while (0)
    SC_LD(0, 0); SC_LD(1, 1); SC_LD(2, 2); SC_LD(3, 3); SC_LD(4, 4); SC_LD(5, 5); SC_LD(6, 6);
    __syncthreads();
#pragma unroll 1
    for (int i = 0; i < 256; i += 8) { SC_STEP(0, 7, i); SC_STEP(1, 0, i + 1); SC_STEP(2, 1, i + 2); SC_STEP(3, 2, i + 3); SC_STEP(4, 3, i + 4); SC_STEP(5, 4, i + 5); SC_STEP(6, 5, i + 6); SC_STEP(7, 6, i + 7); }
    SC_STEP(0, 7, 256); SC_STEP(1, 0, 257); SC_STEP(2, 1, 258); SC_STEP(3, 2, 259);
    static_assert(NCH == 260, "scan tail written for 260 chunks");
#undef SC_LD
#undef SC_STEP
    __syncthreads();
}
DEVI void phase_m2(const Params& p, int l, float* sm) {
    trig_tables(sm);
    if (obx() < 64) { scan_block(p, obx(), sm); return; }
    constexpr int N_F2 = 1024, N_CV = 1040, N_PX = 256, N_CF = 16, N_PC = 32;
    const int G = ogd() - 64, bx = obx() - 64;
    for (int it = bx; it < N_F2; it += G) fft2_item(p, it, sm);
    const bool lastl = (l == NLAYER - 1);
    if (M2_CONV) for (int it = (bx + 64) % G; it < (lastl ? 1024 : N_CV); it += G) conv_item(p, l, it, sm);
    if (M2_POOL) { for (int it = (bx + 32) % G; it < N_PX; it += G) poolx_item(p, it, sm);
        if (!lastl) { for (int it = bx; it < N_CF; it += G) ctxfft_item(p, it, sm);
            for (int it = (bx + 96) % G; it < N_PC; it += G) poolc_item(p, it); } }
}

DEVI void g3_item(const Params& p, int l, int item, float* sm) { unsigned char* const ws = opq(p.ws);
    const int tid = otid(); const int b = item / (4 * NCH), rem = item - b * 4 * NCH, h = rem / NCH, jc = rem - h * NCH;
    int i_f, i_b, rowbase;
    if (jc < 4) { i_f = jc; i_b = 3 - jc; rowbase = T + b * 256 + 64 * jc; } else { const int jx = jc - 4; i_f = 4 + jx; i_b = 4 + 255 - jx; rowbase = b * SEQ + 64 * jx; }
    const float* recf = (const float*)(ws + WS_GD) + (size_t)(((b * 2 + 0) * 4 + h) * NCH + i_f) * GD_REC_F;
    const float* recb = (const float*)(ws + WS_GD) + (size_t)(((b * 2 + 1) * 4 + h) * NCH + i_b) * GD_REC_F;
    float* Qf = sm; float* Sf = sm + 4352; float* Qb = sm + 8448; float* Sb = sm + 12800;
    const int rt = tid >> 5, ct = tid & 31, r0 = 4 * rt, c0 = 2 * ct;
    const bf16_t* Of = (const bf16_t*)(recf + 8192) + 4096; const bf16_t* Ob = (const bf16_t*)(recb + 8192) + 4096;
    const bf16_t* P = (const bf16_t*)(ws + WS_P); bf16_t* Y = (bf16_t*)(ws + WS_NY);
    unsigned vf[4], vb[4], zv[4];
#pragma unroll
    for (int x = 0; x < 4; ++x) { vf[x] = *(const unsigned*)(Of + (r0 + x) * 64 + c0); vb[x] = *(const unsigned*)(Ob + (63 - r0 - x) * 64 + c0);
        zv[x] = *(const unsigned*)(P + (size_t)(rowbase + r0 + x) * PPITCH + 1792 + h * 64 + c0); }
    for (int i = tid; i < 1024; i += 512) { const int r = i >> 4, c4 = (i & 15) * 4;
        { const float4 sf = *(const float4*)(recf + 4096 + i * 4), sb = *(const float4*)(recb + 4096 + i * 4);
          const int ln = i & 63, d0 = 16 * ((i >> 6) & 3) + 4 * (ln >> 4), dv = 16 * (i >> 8) + (ln & 15);
          Sf[(d0 + 0) * 64 + dv] = sf.x; Sf[(d0 + 1) * 64 + dv] = sf.y; Sf[(d0 + 2) * 64 + dv] = sf.z; Sf[(d0 + 3) * 64 + dv] = sf.w;
          Sb[(d0 + 0) * 64 + dv] = sb.x; Sb[(d0 + 1) * 64 + dv] = sb.y; Sb[(d0 + 2) * 64 + dv] = sb.z; Sb[(d0 + 3) * 64 + dv] = sb.w; }
        const uint2 qf = *(const uint2*)((const bf16_t*)(recf + 8192) + r * 64 + c4), qb = *(const uint2*)((const bf16_t*)(recb + 8192) + r * 64 + c4);
        *(float4*)(Qf + r * 68 + c4) = make_float4(__uint_as_float(qf.x << 16), __uint_as_float(qf.x & 0xFFFF0000u), __uint_as_float(qf.y << 16), __uint_as_float(qf.y & 0xFFFF0000u));
        *(float4*)(Qb + r * 68 + c4) = make_float4(__uint_as_float(qb.x << 16), __uint_as_float(qb.x & 0xFFFF0000u), __uint_as_float(qb.y << 16), __uint_as_float(qb.y & 0xFFFF0000u)); }
    __syncthreads();
    float o[4][2];
#pragma unroll
    for (int x = 0; x < 4; ++x) { o[x][0] = __uint_as_float(vf[x] << 16) + __uint_as_float(vb[x] << 16); o[x][1] = __uint_as_float(vf[x] & 0xFFFF0000u) + __uint_as_float(vb[x] & 0xFFFF0000u); }
    for (int d = 0; d < 64; d += 4) {
        float4 qf[4], qb[4];
#pragma unroll
        for (int x = 0; x < 4; ++x) { qf[x] = *(const float4*)(Qf + (r0 + x) * 68 + d); qb[x] = *(const float4*)(Qb + (63 - r0 - x) * 68 + d); }
        const float2 sf0 = *(const float2*)(Sf + (d + 0) * 64 + c0), sf1 = *(const float2*)(Sf + (d + 1) * 64 + c0), sf2 = *(const float2*)(Sf + (d + 2) * 64 + c0), sf3 = *(const float2*)(Sf + (d + 3) * 64 + c0);
        const float2 sb0 = *(const float2*)(Sb + (d + 0) * 64 + c0), sb1 = *(const float2*)(Sb + (d + 1) * 64 + c0), sb2 = *(const float2*)(Sb + (d + 2) * 64 + c0), sb3 = *(const float2*)(Sb + (d + 3) * 64 + c0);
#pragma unroll
        for (int x = 0; x < 4; ++x) {
            o[x][0] += qf[x].x * sf0.x + qf[x].y * sf1.x + qf[x].z * sf2.x + qf[x].w * sf3.x + qb[x].x * sb0.x + qb[x].y * sb1.x + qb[x].z * sb2.x + qb[x].w * sb3.x;
            o[x][1] += qf[x].x * sf0.y + qf[x].y * sf1.y + qf[x].z * sf2.y + qf[x].w * sf3.y + qb[x].x * sb0.y + qb[x].y * sb1.y + qb[x].z * sb2.y + qb[x].w * sb3.y; }
    }
    const float nw0 = inp(p, 26)[l * 64 + c0], nw1 = inp(p, 26)[l * 64 + c0 + 1];
#pragma unroll
    for (int x = 0; x < 4; ++x) { float ss = o[x][0] * o[x][0] + o[x][1] * o[x][1];
        ss += __shfl_xor(ss, 1); ss += __shfl_xor(ss, 2); ss += __shfl_xor(ss, 4); ss += __shfl_xor(ss, 8); ss += __shfl_xor(ss, 16);
        const float rs = rsqrtf(ss * (1.f / 64.f) + EPS); const size_t row = (size_t)(rowbase + r0 + x);
        const float z0 = __uint_as_float(zv[x] << 16), z1 = __uint_as_float(zv[x] & 0xFFFF0000u);
        *(unsigned*)(Y + row * YK + 1024 + h * 64 + c0) = pk2(o[x][0] * rs * nw0 * siluf(z0), o[x][1] * rs * nw1 * siluf(z1)); }
    __syncthreads();
}

DEVI void phase_final(const Params& p) {
    const int tid = otid(); const int lane = tid & 63; const int gw = obx() * 8 + (tid >> 6), ngw = ogd() * 8;
    const float4* nw4 = (const float4*)inp(p, 27);
    float4 w4[4];
#pragma unroll
    for (int q = 0; q < 4; ++q) w4[q] = nw4[lane + 64 * q];
    for (int row = gw; row < T; row += ngw) {
        float4* r4 = (float4*)(outp(p) + (size_t)row * D);
        float4 v[4]; float ss = 0.f;
#pragma unroll
        for (int q = 0; q < 4; ++q) { v[q] = r4[lane + 64 * q]; ss += v[q].x * v[q].x + v[q].y * v[q].y + v[q].z * v[q].z + v[q].w * v[q].w; }
        ss = wave_sum(ss); const float rs = rsqrtf(ss * (1.f / 1024.f) + EPS);
#pragma unroll
        for (int q = 0; q < 4; ++q) r4[lane + 64 * q] = make_float4(v[q].x * rs * w4[q].x, v[q].y * rs * w4[q].y, v[q].z * rs * w4[q].z, v[q].w * rs * w4[q].w);
    }
}

#define XB_TMO      128
#define XB_XCNT(j)  (256  + 64 * (j))
#define XB_XSUB(j)  (1280 + 64 * (j))
#define XB_XGEN(j)  (2304 + 64 * (j))
#define XB_TOP      3328
#define XB_TOPGEN   3392
#define XCD_BAR_WORDS 3456
#define XB_SPIN_CAP (1u << 18)
#define LAS __attribute__((address_space(3)))

__device__ __forceinline__ unsigned xb_ld(unsigned* p)              { return __hip_atomic_load(p, __ATOMIC_RELAXED, __HIP_MEMORY_SCOPE_AGENT); }
__device__ __forceinline__ unsigned xb_add(unsigned* p, unsigned v) { return __hip_atomic_fetch_add(p, v, __ATOMIC_RELAXED, __HIP_MEMORY_SCOPE_AGENT); }
__device__ __forceinline__ unsigned xb_xcc_id() { return (unsigned)__builtin_amdgcn_s_getreg((3 << 11) | 20) & 0xFu; }
#define XB_SPIN(cond, bar) do { unsigned _sp = 0; while (cond) { __builtin_amdgcn_s_sleep(1); \
    if ((++_sp & 255u) == 0u) { if (xb_ld(&(bar)[XB_TMO])) break; if (_sp > XB_SPIN_CAP) { atomicAdd(&(bar)[XB_TMO], 1u); break; } } } } while (0)

struct XcdBarrier {
    unsigned* bar; unsigned x;
    volatile LAS unsigned* st;
};

__device__ __forceinline__ XcdBarrier xcd_barrier_post(unsigned* bar, volatile LAS unsigned* st) {
    XcdBarrier b; b.bar = bar; b.x = xb_xcc_id(); b.st = st;
    if (threadIdx.x == 0) (void)xb_add(&bar[XB_XCNT(b.x)], 1u);
    return b;
}
__device__ __forceinline__ void xcd_barrier_complete(unsigned* bar, unsigned x, unsigned& nloc, unsigned& nx) {
    const unsigned G = gridDim.x * gridDim.y * gridDim.z;
    unsigned sum, cnt, mine, sp = 0u;
    for (;;) {
        sum = 0u; cnt = 0u; mine = 0u;
#pragma unroll
        for (unsigned j = 0; j < 16; ++j) { const unsigned c = xb_ld(&bar[XB_XCNT(j)]); sum += c; cnt += (c > 0u) ? 1u : 0u; mine = (j == x) ? c : mine; }
        if (sum == G) break;
        __builtin_amdgcn_s_sleep(1);
        if ((++sp & 255u) == 0u) { if (xb_ld(&bar[XB_TMO])) break; if (sp > XB_SPIN_CAP) { atomicAdd(&bar[XB_TMO], 1u); break; } }
    }
    nloc = mine > 0u ? mine : 1u; nx = cnt > 0u ? cnt : 1u;
}

__device__ __forceinline__ void xcd_barrier(const XcdBarrier& b) {
    asm volatile("s_waitcnt vmcnt(0)" ::: "memory");
    __syncthreads();
    if (threadIdx.x == 0) {
        unsigned* bar = b.bar;
        __builtin_amdgcn_s_waitcnt(0);
        unsigned nloc = b.st[0], nx = b.st[1];
        if (nloc == 0u) { xcd_barrier_complete(bar, b.x, nloc, nx); b.st[0] = nloc; b.st[1] = nx; }
        const unsigned old = xb_add(&bar[XB_XSUB(b.x)], 1u);
        const unsigned gen = old / nloc;
        if (old + 1u == (gen + 1u) * nloc) {
            __builtin_amdgcn_fence(__ATOMIC_RELEASE, "agent");
            asm volatile("s_waitcnt vmcnt(0)" ::: "memory");
            const unsigned og = xb_add(&bar[XB_TOP], 1u);
            const unsigned tg = og / nx;
            if (og + 1u == (tg + 1u) * nx) xb_add(&bar[XB_TOPGEN], 1u);
            else XB_SPIN(xb_ld(&bar[XB_TOPGEN]) == tg, bar);
            __builtin_amdgcn_fence(__ATOMIC_ACQUIRE, "agent");
            xb_add(&bar[XB_XGEN(b.x)], 1u);
            asm volatile("s_waitcnt vmcnt(0)" ::: "memory");
        } else {
            XB_SPIN(xb_ld(&bar[XB_XGEN(b.x)]) == gen, bar);
            __builtin_amdgcn_fence(__ATOMIC_ACQUIRE, "agent");
            asm volatile("s_waitcnt vmcnt(0)" ::: "memory");
        }
    }
    __syncthreads();
}


#ifndef MK_ALIGN
#define MK_ALIGN true
#endif
#ifndef MK_SP2
#define MK_SP2 true
#endif
constexpr int N_PHASES = 2 + 12 * NLAYER;
__global__ void __launch_bounds__(512, 2) mega_fwd(Params p) {
    extern __shared__ __attribute__((aligned(16))) unsigned char lds[];
    float* sm = (float*)lds;
    PG8_LAS unsigned char* glds = (PG8_LAS unsigned char*)lds;
    cg::grid_group grid = cg::this_grid();
    volatile LAS unsigned* xst = (volatile LAS unsigned*)(lds + LDS_BYTES - 16);
    if (threadIdx.x == 0) { xst[0] = 0u; xst[1] = 0u; }
    __syncthreads();
    const XcdBarrier xb = xcd_barrier_post((unsigned*)(p.ws + WS_BAR), xst);
    pg8::StaticOrder S;
    int rep_done = 0;
#pragma unroll 1
    for (int ph = p.ph_lo; ph < p.ph_hi; ++ph) {
        unsigned char* const ws = opq(p.ws);
        if (ph == 0) { if (!(SKIPM & 1)) phase_init(p, sm); }
        else if (ph == N_PHASES - 1) phase_final(p);
        else {
            const int l = (ph - 1) / 12, s = (ph - 1) % 12;
            if (s == 3 || s == 9) continue;
            const float* MODL = (const float*)(ws + WS_MOD) + (size_t)l * 3 * 9216;
            switch (s) {
            case 0: if (!(SKIPM & 2)) phase_prep(p, l, sm); break;
            case 1: case 10: if (!(SKIPM & 4)) {
                const int Mup = (s == 10 && l == NLAYER - 1) ? T : MROWS;
                S.init(Mup, 2 * FH, ogd(), obx());
                pg8::Gemm g{(const bf16_t*)(ws + (s == 1 ? WS_NY : WS_GD)), (const bf16_t*)(ws + (s == 1 ? WS_WUP1 : WS_WUP2)), Mup, 2 * FH, 1024};
                EpiUp E{(bf16_t*)(ws + WS_H), (const float*)(ws + WS_RS + (s == 1 ? 0 : 2) * RS_STRIDE), (const float*)(ws + WS_BIAS) + (size_t)(s == 1 ? 0 : 2) * 3 * 5632};
                pg8::gemm_phase<decltype(E), pg8::StaticOrder, MK_ALIGN, MK_SP2>(glds, g, S, E); } break;
            case 2: case 8: case 11: if (!(SKIPM & 8)) {
                const int K = s == 8 ? YK : FH;
                const bf16_t* A = (const bf16_t*)(ws + (s == 8 ? WS_NY : WS_H)); const bf16_t* W = (const bf16_t*)(ws + (s == 2 ? WS_WDN1 : s == 8 ? WS_WOUT : WS_WDN2));
                const float* gate = MODL + (s == 2 ? 2 : s == 8 ? 5 : 8) * 1024; const float mult = s == 8 ? 1.f : 0.5f;
                S.init(T, 1024, ogd(), obx());
                pg8::Gemm g{A, W, T, 1024, K};
                const bool feeds = !(s == 11 && l == NLAYER - 1);
                bf16_t* nyraw = feeds ? (bf16_t*)(ws + (s == 8 ? WS_GD : WS_NY)) : nullptr; float* rsacc = (float*)(ws + WS_RS + (s == 2 ? 1 : s == 8 ? 2 : 0) * RS_STRIDE);
                const int nl = s == 11 ? l + 1 : l, nwhich = s == 2 ? 1 : s == 8 ? 2 : 0;
                const float* nw = inp(p, 6) + ((size_t)(feeds ? nl : l) * 3 + nwhich) * 1024; const float* nscale = (const float*)(ws + WS_MOD) + (size_t)(feeds ? nl : l) * 3 * 9216 + (3 * nwhich + 1) * 1024;
                const bool first = (l == 0 && s == 2);
                const EpiRes E{outp(p), (float*)(ws + WS_CTXR), first ? inp(p, 0) : (const float*)outp(p), gate, nyraw, rsacc, nw, nscale, mult, feeds ? 1 : 0};
                pg8::gemm_phase<decltype(E), pg8::StaticOrder, MK_ALIGN, MK_SP2>(glds, g, S, E);
                if (!(l == NLAYER - 1 && s != 2)) mini_res(p, A, W, K, gate, mult, nyraw, rsacc, nw, nscale, first ? inp(p, 2) : (const float*)(ws + WS_CTXR), sm); } break;
            case 4: if (!(SKIPM & 16)) {
                S.init(MROWS, PN, ogd(), obx());
                pg8::Gemm g{(const bf16_t*)(ws + WS_NY), (const bf16_t*)(ws + WS_WIN), MROWS, PN, 1024};
                EpiP E{(bf16_t*)(ws + WS_P), (const float*)(ws + WS_RS + RS_STRIDE), (const float*)(ws + WS_BIAS) + (size_t)3 * 5632};
                pg8::gemm_phase<decltype(E), pg8::StaticOrder, MK_ALIGN, MK_SP2>(glds, g, S, E);
                { float* RS0 = (float*)(ws + WS_RS); float* RS2 = (float*)(ws + WS_RS + 2 * RS_STRIDE);
                  for (int i = obx() * 512 + otid(); i < MROWS; i += ogd() * 512) { RS0[i] = 0.f; RS2[i] = 0.f; } } } break;
            case 5: if (!(SKIPM & 32)) phase_m1(p, l, sm); break;
            case 6: if (!(SKIPM & 64)) phase_m2(p, l, sm); break;
            case 7: if (!(SKIPM & 128)) {
                if (l == NLAYER - 1) { for (int it = obx(); it < 2048; it += ogd()) g3_item(p, l, (it >> 8) * NCH + 4 + (it & 255), sm); }
                else for (int it = obx(); it < 2 * 4 * NCH; it += ogd()) g3_item(p, l, it, sm); } break;
            }
        }
#if REPM
        {
            const int s_ = (ph >= 1 && ph < N_PHASES - 1) ? (ph - 1) % 12 : -1;
            if (s_ >= 0) {
                if (((REPM >> s_) & 1) && s_ != 6) { if (!rep_done) { rep_done = 1; --ph; } else rep_done = 0; }
                if ((REPM & 4096) && s_ == 6) { if (!rep_done) { rep_done = 1; ph -= 2; } else rep_done = 0; }
            }
        }
#endif
        if (ph + 1 < p.ph_hi) { if (p.ph_lo < 0) grid.sync(); else xcd_barrier(xb); }
    }
}

#ifndef MK_PER_PHASE
#define MK_PER_PHASE 0
#endif
extern "C" void kernel_launch(void* const* d_in, const int* in_sizes, int n_in, void* d_out, int out_size, void* d_ws, size_t ws_size, hipStream_t stream) {
    static int grid = 0;
    if (grid == 0) {
        if (n_in != 28 || out_size != T * D || ws_size < WS_TOTAL) { fprintf(stderr, "kernel_launch: unexpected shapes (n_in %d, out %d, ws %zu < %zu)\n", n_in, out_size, ws_size, (size_t)WS_TOTAL); grid = -1; return; }
        int dev = 0, cus = 0, per_cu = 0;
        (void)hipGetDevice(&dev); (void)hipDeviceGetAttribute(&cus, hipDeviceAttributeMultiprocessorCount, dev);
        if (hipFuncSetAttribute((const void*)mega_fwd, hipFuncAttributeMaxDynamicSharedMemorySize, LDS_BYTES) != hipSuccess) { fprintf(stderr, "kernel_launch: hipFuncSetAttribute failed\n"); grid = -1; return; }
        if (hipOccupancyMaxActiveBlocksPerMultiprocessor(&per_cu, (const void*)mega_fwd, 512, LDS_BYTES) != hipSuccess || per_cu < 1) { fprintf(stderr, "kernel_launch: occupancy query says %d\n", per_cu); per_cu = 1; }
        (void)hipGetLastError();
        grid = cus * 1;
        if (grid < 128) { fprintf(stderr, "kernel_launch: %d CUs?\n", grid); grid = -1; return; }
    }
    if (grid < 0) return;
    Params p{};
    for (int i = 0; i < 28; ++i) p.in[i] = (const float*)d_in[i];
    p.out = (float*)d_out; p.ws = (unsigned char*)d_ws;
#if MK_PER_PHASE
    for (int ph = 0; ph < N_PHASES; ++ph) { p.ph_lo = ph; p.ph_hi = ph + 1; hipLaunchKernelGGL(mega_fwd, dim3(grid), dim3(512), LDS_BYTES, stream, p); }
#else
    p.ph_lo = 0; p.ph_hi = N_PHASES;
    (void)hipMemsetAsync((unsigned char*)d_ws + WS_BAR, 0, XCD_BAR_WORDS * sizeof(unsigned), stream);
    void* args[] = {&p};
    const hipError_t e = hipLaunchCooperativeKernel((const void*)mega_fwd, dim3(grid), dim3(512), args, LDS_BYTES, stream);
    if (e != hipSuccess) fprintf(stderr, "kernel_launch: cooperative launch failed: %s (grid %d)\n", hipGetErrorString(e), grid);
#endif
}
```

```cpp
#define M2_CONV 1
#define M2_POOL 1
#include <hip/hip_runtime.h>
#include <hip/hip_cooperative_groups.h>
#include <cstdio>
namespace cg = cooperative_groups;
#define DEVI __device__ __forceinline__
namespace pg8 {
#define PG8_LAS __attribute__((address_space(3)))
typedef unsigned short bf16_t;
typedef short bf16x8 __attribute__((ext_vector_type(8)));
typedef float f32x4 __attribute__((ext_vector_type(4)));
typedef unsigned u32x4 __attribute__((ext_vector_type(4)));
constexpr int BM = 256, BK = 64, HALF = 128, HTB = HALF * BK * 2  , STAGE_BYTES = 8 * HTB, NXCD = 8, WGM = 8;

__host__ __device__ __forceinline__ int lds_byte(int r, int c) { const int st = (r >> 4) * 2 + (c >> 5), rr = r & 15, cc = c & 31, ob = rr * 64 + cc * 2; return st * 1024 + (ob ^ (((ob >> 9) & 1) << 5)); }
__host__ __device__ __forceinline__ void stage_rc(int b, int& R, int& C) { const int st = b / 1024, sb = b % 1024, swz = sb ^ (((sb >> 9) & 1) << 5); R = (st >> 1) * 16 + swz / 64; C = (st & 1) * 32 + (swz % 64) / 2; }
__host__ __device__ __forceinline__ int perm32(int rho) { const int n = rho >> 4, i = rho & 15; return 8 * (i >> 2) + 4 * n + (i & 3); }

struct Unit { int pm, pn; };
struct Gemm { const bf16_t* A; const bf16_t* Bt; int M, N, K; };
struct StaticOrder {
    int nM, nN, nwg, G, c;
    __host__ __device__ void init(int M, int N, int G_, int c_) { nM = M / BM; nN = N / BM; nwg = nM * nN; G = G_; c = c_; }
    __host__ __device__ bool next(int i, Unit& u) const {
        const long L = (long)i * G + c; if (L >= nwg) return false;
        int wgid = (int)L; { const int q = nwg / NXCD, r = nwg % NXCD, xcd = wgid % NXCD, off = wgid / NXCD; wgid = (xcd < r ? xcd * (q + 1) : r * (q + 1) + (xcd - r) * q) + off; }
        const int nig = WGM * nN, gid = wgid / nig, fm = gid * WGM, gsz = (nM - fm) < WGM ? (nM - fm) : WGM;
        u.pm = fm + ((wgid % nig) % gsz); u.pn = (wgid % nig) / gsz; return true;
    }
    __device__ __forceinline__ void a_ready(const Unit&) const {}
    __device__ __forceinline__ void done(const Unit&) const {}
};
__device__ __forceinline__ unsigned cvt_pk_bf16(float lo, float hi) { unsigned r; asm volatile("v_cvt_pk_bf16_f32 %0, %1, %2" : "=v"(r) : "v"(lo), "v"(hi)); return r; }
template <class Epi, class Sched, bool ALIGN_EPI = false, bool SP2 = false>
__device__ __forceinline__ void gemm_phase(PG8_LAS unsigned char* lds, const Gemm g, const Sched& S, const Epi& E) {
    int tid_ = threadIdx.x; asm volatile("" : "+v"(tid_));
    const int tid = tid_, wid = __builtin_amdgcn_readfirstlane(tid >> 6), lane = tid & 63, wr = wid >> 2, wc = wid & 3, fr = lane & 15, fq = lane >> 4;
    const int K = g.K, nt = K / BK;
    unsigned voffA[2], voffB[2];
#pragma unroll
    for (int i = 0; i < 2; ++i) { int R, C; stage_rc(tid * 16 + i * 8192, R, C); const int Rb = Epi::PERM ? ((R & ~31) + perm32(R & 31)) : R;
        voffA[i] = (unsigned)(R * K + C) * 2u; voffB[i] = (unsigned)(Rb * K + C) * 2u; }
    const size_t kstep = (size_t)(BK * 2);
    const size_t hstep = (size_t)HALF * K * 2;
    const size_t tstep = 2 * hstep;
    const unsigned ldsw = (unsigned)wid * 1024u;
    const int aoff = lds_byte(wr * 64 + fr, fq * 8), boff = lds_byte(wc * 32 + fr, fq * 8);
#define PG8_SA(b, h) (((b) * 2 + (h)) * HTB)
#define PG8_SB(b, h) ((4 + (b) * 2 + (h)) * HTB)
#define PG8_STAGE(bufoff, gbase, voff) do { _Pragma("unroll") for (int _i = 0; _i < 2; ++_i) \
        __builtin_amdgcn_global_load_lds((const unsigned*)((const char*)(gbase) + (voff)[_i]), (PG8_LAS unsigned*)(lds + (bufoff) + ldsw + _i * 8192), 16, 0, 0); } while (0)
#define PG8_LDA(dst, b, h) do { _Pragma("unroll") for (int m = 0; m < 4; ++m) _Pragma("unroll") for (int k = 0; k < 2; ++k) dst[m][k] = *(const PG8_LAS bf16x8*)(lds + PG8_SA(b, h) + aoff + m * 2048 + k * 1024); } while (0)
#define PG8_LDB(dst, b, h) do { _Pragma("unroll") for (int n = 0; n < 2; ++n) _Pragma("unroll") for (int k = 0; k < 2; ++k) dst[n][k] = *(const PG8_LAS bf16x8*)(lds + PG8_SB(b, h) + boff + n * 2048 + k * 1024); } while (0)
#define PG8_MMA(ai, bj, At, Bt) do { __builtin_amdgcn_s_setprio(1); _Pragma("unroll") for (int m = 0; m < 4; ++m) _Pragma("unroll") for (int n = 0; n < 2; ++n) _Pragma("unroll") for (int k = 0; k < 2; ++k) \
        acc[ai][bj][m][n] = __builtin_amdgcn_mfma_f32_16x16x32_bf16(Bt[n][k], At[m][k], acc[ai][bj][m][n], 0, 0, 0); __builtin_amdgcn_s_setprio(0); } while (0)
#define PG8_WAIT_V(n) asm volatile("s_waitcnt vmcnt(" #n ")" ::: "memory")
#define PG8_WAIT_L(n) asm volatile("s_waitcnt lgkmcnt(" #n ")" ::: "memory")
#define PG8_BAR __builtin_amdgcn_s_barrier()
#define PG8_SCHED __builtin_amdgcn_sched_barrier(0)
    Unit cur, nxt; int ui = 0;
    if (!S.next(0, cur)) return;
    f32x4 acc[2][2][4][2];
#pragma unroll
    for (int a = 0; a < 2; ++a)
#pragma unroll
        for (int b = 0; b < 2; ++b)
#pragma unroll
            for (int m = 0; m < 4; ++m)
#pragma unroll
                for (int n = 0; n < 2; ++n) acc[a][b][m][n] = (f32x4){0.f, 0.f, 0.f, 0.f};
    bf16x8 At[4][2], B0[2][2], B1[2][2];
    const char* cA = (const char*)g.A + (size_t)cur.pm * tstep; const char* cB = (const char*)g.Bt + (size_t)cur.pn * tstep;
    S.a_ready(cur);
    if constexpr (SP2) {
        PG8_STAGE(PG8_SB(0, 0), cB, voffB); PG8_STAGE(PG8_SB(0, 1), cB + hstep, voffB); PG8_STAGE(PG8_SA(0, 0), cA, voffA); PG8_STAGE(PG8_SA(0, 1), cA + hstep, voffA);
        if (wr == 1) PG8_BAR;
        PG8_WAIT_V(2); PG8_BAR;
        PG8_STAGE(PG8_SB(1, 0), cB + kstep, voffB); PG8_STAGE(PG8_SA(1, 0), cA + kstep, voffA); PG8_STAGE(PG8_SB(1, 1), cB + hstep + kstep, voffB);
        PG8_WAIT_V(6); PG8_BAR;
    } else {
        PG8_STAGE(PG8_SB(0, 0), cB, voffB); PG8_STAGE(PG8_SA(0, 0), cA, voffA); PG8_STAGE(PG8_SB(0, 1), cB + hstep, voffB); PG8_STAGE(PG8_SA(0, 1), cA + hstep, voffA);
        if (wr == 1) PG8_BAR;
        PG8_WAIT_V(4); PG8_BAR;
        PG8_STAGE(PG8_SB(1, 0), cB + kstep, voffB); PG8_STAGE(PG8_SA(1, 0), cA + kstep, voffA); PG8_STAGE(PG8_SB(1, 1), cB + hstep + kstep, voffB);
        PG8_WAIT_V(6); PG8_BAR;
    }
    for (;;) {
        const bool has_next = S.next(ui + 1, nxt);
        const char* nA = has_next ? (const char*)g.A + (size_t)nxt.pm * tstep : cA; const char* nB = has_next ? (const char*)g.Bt + (size_t)nxt.pn * tstep : cB;
        for (int t = 0; t < nt; t += 2) {
            const bool last = (t == nt - 2);
            const char* a1 = cA + (size_t)(t + 1) * kstep;
            const char* a2 = last ? nA : cA + (size_t)(t + 2) * kstep; const char* b2 = last ? nB : cB + (size_t)(t + 2) * kstep;
            const char* a3 = a2 + kstep; const char* b3 = b2 + kstep;
            if (last && has_next) S.a_ready(nxt);
            if constexpr (SP2) {
            PG8_LDB(B0, 0, 0); PG8_LDB(B1, 0, 1); PG8_SCHED; PG8_LDA(At, 0, 0); PG8_STAGE(PG8_SA(1, 1), a1 + hstep, voffA);
            PG8_WAIT_V(8); PG8_WAIT_L(0); PG8_BAR; PG8_MMA(0, 0, At, B0); PG8_MMA(0, 1, At, B1); PG8_BAR; PG8_SCHED;
            PG8_LDA(At, 0, 1); PG8_STAGE(PG8_SB(0, 0), b2, voffB); PG8_STAGE(PG8_SB(0, 1), b2 + hstep, voffB); PG8_STAGE(PG8_SA(0, 0), a2, voffA);
            PG8_WAIT_V(8); PG8_WAIT_L(0); PG8_BAR; PG8_MMA(1, 0, At, B0); PG8_MMA(1, 1, At, B1); PG8_BAR; PG8_SCHED;
            PG8_LDB(B0, 1, 0); PG8_LDB(B1, 1, 1); PG8_SCHED; PG8_LDA(At, 1, 0); PG8_STAGE(PG8_SA(0, 1), a2 + hstep, voffA);
            PG8_WAIT_V(8); PG8_WAIT_L(0); PG8_BAR; PG8_MMA(0, 0, At, B0); PG8_MMA(0, 1, At, B1); PG8_BAR; PG8_SCHED;
            PG8_LDA(At, 1, 1); PG8_STAGE(PG8_SB(1, 0), b3, voffB); PG8_STAGE(PG8_SB(1, 1), b3 + hstep, voffB); PG8_STAGE(PG8_SA(1, 0), a3, voffA);
            PG8_WAIT_V(8); PG8_WAIT_L(0); PG8_BAR; PG8_MMA(1, 0, At, B0); PG8_MMA(1, 1, At, B1); PG8_BAR; PG8_SCHED;
            } else {
            PG8_LDB(B0, 0, 0); PG8_SCHED; PG8_LDA(At, 0, 0); PG8_STAGE(PG8_SA(1, 1), a1 + hstep, voffA);
            PG8_WAIT_L(8); PG8_BAR; PG8_WAIT_L(0); PG8_MMA(0, 0, At, B0); PG8_BAR; PG8_SCHED;
            PG8_LDB(B1, 0, 1); PG8_STAGE(PG8_SB(0, 0), b2, voffB);
            PG8_BAR; PG8_WAIT_L(0); PG8_MMA(0, 1, At, B1); PG8_BAR;
            PG8_LDA(At, 0, 1); PG8_STAGE(PG8_SA(0, 0), a2, voffA);
            PG8_BAR; PG8_WAIT_L(0); PG8_MMA(1, 0, At, B0); PG8_BAR; PG8_SCHED;
            PG8_STAGE(PG8_SB(0, 1), b2 + hstep, voffB);
            PG8_WAIT_V(6); PG8_BAR; PG8_MMA(1, 1, At, B1); PG8_BAR;
            PG8_LDB(B0, 1, 0); PG8_SCHED; PG8_LDA(At, 1, 0); PG8_STAGE(PG8_SA(0, 1), a2 + hstep, voffA);
            PG8_WAIT_L(8); PG8_BAR; PG8_WAIT_L(0); PG8_MMA(0, 0, At, B0); PG8_BAR; PG8_SCHED;
            PG8_LDB(B1, 1, 1); PG8_STAGE(PG8_SB(1, 0), b3, voffB);
            PG8_BAR; PG8_WAIT_L(0); PG8_MMA(0, 1, At, B1); PG8_BAR;
            PG8_LDA(At, 1, 1); PG8_STAGE(PG8_SA(1, 0), a3, voffA);
            PG8_BAR; PG8_WAIT_L(0); PG8_MMA(1, 0, At, B0); PG8_BAR; PG8_SCHED;
            PG8_STAGE(PG8_SB(1, 1), b3 + hstep, voffB);
            PG8_WAIT_V(6); PG8_BAR; PG8_MMA(1, 1, At, B1); PG8_BAR;
            }
        }
        if constexpr (ALIGN_EPI) { if (wr == 0) PG8_BAR; }
        if constexpr (!Epi::AFTER_DRAIN) { E(acc, cur, wr, wc, fr, fq); S.done(cur); }
        if (!has_next) break;
#pragma unroll
        for (int a = 0; a < 2; ++a)
#pragma unroll
            for (int b = 0; b < 2; ++b)
#pragma unroll
                for (int m = 0; m < 4; ++m)
#pragma unroll
                    for (int n = 0; n < 2; ++n) acc[a][b][m][n] = (f32x4){0.f, 0.f, 0.f, 0.f};
        cur = nxt; cA = nA; cB = nB; ++ui;
        if constexpr (ALIGN_EPI) { if (wr == 1) PG8_BAR; }
    }
    PG8_WAIT_V(0);
    if constexpr (!ALIGN_EPI) { if (wr == 0) PG8_BAR; }
    PG8_BAR;
    if constexpr (Epi::AFTER_DRAIN) { E.fused(acc, cur, wr, wc, fr, fq, lds, wid, lane); S.done(cur); }
#undef PG8_SA
#undef PG8_SB
#undef PG8_STAGE
#undef PG8_LDA
#undef PG8_LDB
#undef PG8_MMA
#undef PG8_WAIT_V
#undef PG8_WAIT_L
#undef PG8_BAR
#undef PG8_SCHED
}
}
#ifndef SKIPM
#define SKIPM 0
#endif
#ifndef REPM
#define REPM 0
#endif
using pg8::bf16_t; using pg8::f32x4; using pg8::u32x4; using pg8::Unit;

constexpr int D = 1024, SEQ = 16384, T = 32768, TC = 512, MROWS = 33280, FH = 2816, NLAYER = 4;
constexpr int PPITCH = 2080, PN = 2304, YK = 1280, NCH = 260;
constexpr float EPS = 1e-6f;
constexpr size_t WS_WUP1 = 0;
constexpr size_t WS_WDN1 = WS_WUP1 + (size_t)5632 * 1024 * 2;
constexpr size_t WS_WUP2 = WS_WDN1 + (size_t)1024 * 2816 * 2;
constexpr size_t WS_WDN2 = WS_WUP2 + (size_t)5632 * 1024 * 2;
constexpr size_t WS_WIN  = WS_WDN2 + (size_t)1024 * 2816 * 2;
constexpr size_t WS_WOUT = WS_WIN + (size_t)PN * 1024 * 2;
constexpr size_t WS_MOD  = WS_WOUT + (size_t)1024 * YK * 2;
constexpr size_t WS_CF   = WS_MOD + (size_t)4 * 3 * 9216 * 4;
constexpr size_t WS_CTXR = WS_CF + (size_t)4 * 2 * 65536 * 4;
constexpr size_t WS_NY   = WS_CTXR + (size_t)TC * D * 4;
constexpr size_t WS_U    = WS_NY + (size_t)MROWS * YK * 2;
constexpr size_t WS_H    = WS_U;
constexpr size_t WS_P    = WS_U;
constexpr size_t WS_FS   = WS_P + (size_t)MROWS * PPITCH * 2;
constexpr size_t WS_GD   = WS_FS + (size_t)2 * 16384 * 256 * 8;
constexpr size_t GD_REC_F = 12288;
constexpr size_t WS_END  = WS_GD + (size_t)16 * NCH * GD_REC_F * 4;
static_assert(WS_U + (size_t)MROWS * FH * 2 <= WS_END, "H fits");
constexpr size_t WS_BAR = WS_END;
constexpr size_t WS_RS = WS_BAR + 16384;
constexpr size_t RS_STRIDE = (size_t)MROWS * 4;
constexpr size_t WS_BIAS = WS_RS + 3 * RS_STRIDE;
constexpr size_t WS_TOTAL = WS_BIAS + (size_t)3 * 3 * 5632 * 4;
constexpr int LDS_BYTES = 160 * 1024;
constexpr int TAB_OFF = 32768;

struct Params { const float* in[28]; float* out; unsigned char* ws; int ph_lo, ph_hi; };

#define GASP __attribute__((address_space(1)))
DEVI unsigned char* opq(unsigned char* x) { GASP unsigned char* g = (GASP unsigned char*)x; asm volatile("" : "+s"(g)); return (unsigned char*)g; }
DEVI const float* inp(const Params& p, int i) { asm volatile("" : "+s"(i)); GASP const float* g = (GASP const float*)p.in[i]; asm volatile("" : "+s"(g)); return (const float*)g; }
DEVI float* outp(const Params& p) { GASP float* g = (GASP float*)p.out; asm volatile("" : "+s"(g)); return (float*)g; }
DEVI int obx() { int b = blockIdx.x; asm volatile("" : "+s"(b)); return b; }
DEVI int ogd() { int b = gridDim.x; asm volatile("" : "+s"(b)); return b; }
DEVI int otid() { int t = threadIdx.x; asm volatile("" : "+v"(t)); return t; }
DEVI float bf2f(unsigned short b) { return __uint_as_float(((unsigned)b) << 16); }
DEVI unsigned pk2(float a, float b) { unsigned r; asm("v_cvt_pk_bf16_f32 %0, %1, %2" : "=v"(r) : "v"(a), "v"(b)); return r; }
DEVI unsigned short f2bf(float f) { return (unsigned short)(pk2(f, 0.f) & 0xFFFFu); }
DEVI float sigmf(float x) { return __builtin_amdgcn_rcpf(1.f + __expf(-x)); }
DEVI float siluf(float x) { return x * sigmf(x); }
DEVI float wave_sum(float v) {
#pragma unroll
    for (int o = 1; o < 64; o <<= 1) v += __shfl_xor(v, o);
    return v;
}
#define UNPACK8(v, f) do { (f)[0] = __uint_as_float((v).x << 16); (f)[1] = __uint_as_float((v).x & 0xFFFF0000u); (f)[2] = __uint_as_float((v).y << 16); (f)[3] = __uint_as_float((v).y & 0xFFFF0000u); \
    (f)[4] = __uint_as_float((v).z << 16); (f)[5] = __uint_as_float((v).z & 0xFFFF0000u); (f)[6] = __uint_as_float((v).w << 16); (f)[7] = __uint_as_float((v).w & 0xFFFF0000u); } while (0)
DEVI float* res_row(const Params& p, int row) { return row < T ? outp(p) + (size_t)row * D : (float*)(opq(p.ws) + WS_CTXR) + (size_t)(row - T) * D; }

DEVI void phase_init(const Params& p, float* sm) { unsigned char* const ws = opq(p.ws);
    const int tid = otid(), lane = tid & 63, wv = tid >> 6;
    const size_t gt = (size_t)obx() * 512 + tid, gs = (size_t)ogd() * 512;
    float* sv = sm;
    float* red = sm + 3072;
    float* tc = sm + 3072 + 1536;
    for (int i = tid; i < 3072; i += 512) { const float v = i < 2048 ? inp(p, 1)[i] : inp(p, 3)[i - 2048]; sv[i] = siluf(v); }
    if (tid < 64) { float s, c; sincospif((float)tid * (1.f / 32.f), &s, &c); tc[tid] = c; tc[64 + tid] = s; }
    __syncthreads();
    const float* mw = inp(p, 4); const float* mb = inp(p, 5); float* MOD = (float*)(ws + WS_MOD);
    for (int item = obx(); item < 576; item += ogd()) {
        const int gc = item * 64 + lane, l = gc / 9216, j = gc - l * 9216;
        const float* w = mw + ((size_t)l * 1024 + wv * 128) * 9216 + j;
        float a0 = 0.f, a1 = 0.f, a2 = 0.f;
#pragma unroll 8
        for (int k = 0; k < 128; ++k) { const float x = w[(size_t)k * 9216]; const int kk = wv * 128 + k; a0 += sv[kk] * x; a1 += sv[1024 + kk] * x; a2 += sv[2048 + kk] * x; }
        red[(wv * 3 + 0) * 64 + lane] = a0; red[(wv * 3 + 1) * 64 + lane] = a1; red[(wv * 3 + 2) * 64 + lane] = a2;
        __syncthreads();
        if (tid < 192) { const int r = tid >> 6; float s = mb[(size_t)l * 9216 + j];
#pragma unroll
            for (int w8 = 0; w8 < 8; ++w8) s += red[(w8 * 3 + r) * 64 + lane];
            MOD[((size_t)l * 3 + r) * 9216 + j] = s; }
        __syncthreads();
    }
    const float* fw = inp(p, 17); float* CF = (float*)(ws + WS_CF);
    for (size_t idx = gt; idx < 524288; idx += gs) {
        const int k = (int)(idx & 255), row = (int)((idx >> 8) & 255), t = (int)((idx >> 16) & 1), l = (int)(idx >> 17);
        const int g = row >> 6, c = row & 63;
        const float* f = fw + ((size_t)l * 256 + g * 64) * 256 + k; const float* tab = tc + t * 64; float s = 0.f;
        for (int m = 0; m < 64; ++m) s += tab[(c * m) & 63] * f[m * 256];
        CF[idx] = s;
    }
}

DEVI void transpose_wave(const float* src, int N, int k0, int n0, bf16_t* dst, int K, int drow0, float* scr, int lane) {
    float v[32]; const int n = n0 + (lane & 31);
#pragma unroll
    for (int i = 0; i < 32; ++i) v[i] = n < N ? src[(size_t)(k0 + 2 * i + (lane >> 5)) * N + n] : 0.f;
#pragma unroll
    for (int i = 0; i < 32; ++i) scr[(2 * i + (lane >> 5)) * 33 + (lane & 31)] = v[i];
    asm volatile("s_waitcnt lgkmcnt(0)" ::: "memory");
    const int c = lane & 7;
#pragma unroll
    for (int j = 0; j < 4; ++j) { const int nn = (lane >> 3) + 8 * j; const float* t = scr + (8 * c) * 33 + nn;
        uint4 o; o.x = pk2(t[0], t[33]); o.y = pk2(t[66], t[99]); o.z = pk2(t[132], t[165]); o.w = pk2(t[198], t[231]);
        *(uint4*)(dst + (size_t)(drow0 + nn) * K + k0 + 8 * c) = o; }
    asm volatile("s_waitcnt lgkmcnt(0)" ::: "memory");
}

DEVI void raw_rows(const Params& p) { unsigned char* const ws = opq(p.ws);
    const int tid = otid(); const int lane = tid & 63; const int gw = obx() * 8 + (tid >> 6), ngw = ogd() * 8;
    const float4* nw4 = (const float4*)inp(p, 6);
    const float* MOD = (const float*)(ws + WS_MOD);
    bf16_t* NY = (bf16_t*)(ws + WS_NY); float* RS0 = (float*)(ws + WS_RS);
    float4 w4[4];
#pragma unroll
    for (int q = 0; q < 4; ++q) w4[q] = nw4[lane + 64 * q];
    for (int row = gw; row < MROWS; row += ngw) {
        const float4* r4 = (const float4*)(row < T ? inp(p, 0) + (size_t)row * D : inp(p, 2) + (size_t)(row - T) * D); const int mr = row < SEQ ? 0 : (row < T ? 1 : 2);
        const float4* sc4 = (const float4*)(MOD + (size_t)mr * 9216 + 1024);
        float4 v[4]; float ss = 0.f;
#pragma unroll
        for (int q = 0; q < 4; ++q) { v[q] = r4[lane + 64 * q]; ss += v[q].x * v[q].x + v[q].y * v[q].y + v[q].z * v[q].z + v[q].w * v[q].w; }
        ss = wave_sum(ss); if (lane == 0) RS0[row] = ss;
#pragma unroll
        for (int q = 0; q < 4; ++q) { const float4 c = sc4[lane + 64 * q];
            uint2 o; o.x = pk2(v[q].x * w4[q].x * (1.f + c.x), v[q].y * w4[q].y * (1.f + c.y)); o.y = pk2(v[q].z * w4[q].z * (1.f + c.z), v[q].w * w4[q].w * (1.f + c.w));
            *(uint2*)(NY + (size_t)row * 1024 + (lane + 64 * q) * 4) = o; }
    }
}

DEVI void phase_prep(const Params& p, int l, float* sm) { unsigned char* const ws = opq(p.ws);
    const int tid = otid();
    constexpr int NT_UP = 16 * 88, NT_DN = 44 * 32, NT_IN = 16 * 65, TOTAL = 4 * NT_UP + 2 * NT_DN + NT_IN;
    { const int lane = tid & 63, wv = __builtin_amdgcn_readfirstlane(tid >> 6); float* scr = sm + wv * 2112;
      for (int it = obx() * 8 + wv; it < TOTAL; it += ogd() * 8) {
        int r = it;
        if (r < 4 * NT_UP) { const int which = r / NT_UP; r -= which * NT_UP; const int kt = r / 88, nt = r % 88;
            const float* src = inp(p, which == 0 ? 7 : which == 1 ? 8 : which == 2 ? 10 : 11) + (size_t)l * 1024 * FH;
            const int n0 = nt * 32, drow0 = 256 * (n0 >> 7) + 128 * (which & 1) + (n0 & 127);
            transpose_wave(src, FH, kt * 64, n0, (bf16_t*)(ws + ((which >> 1) ? WS_WUP2 : WS_WUP1)), 1024, drow0, scr, lane);
        } else if ((r -= 4 * NT_UP) < 2 * NT_DN) { const int which = r / NT_DN; r -= which * NT_DN; const int kt = r / 32, nt = r % 32;
            transpose_wave(inp(p, which ? 12 : 9) + (size_t)l * FH * 1024, 1024, kt * 64, nt * 32, (bf16_t*)(ws + (which ? WS_WDN2 : WS_WDN1)), FH, nt * 32, scr, lane);
        } else { r -= 2 * NT_DN; const int kt = r / 65, nt = r % 65;
            transpose_wave(inp(p, 13) + (size_t)l * 1024 * 2064, 2064, kt * 64, nt * 32, (bf16_t*)(ws + WS_WIN), 1024, nt * 32, scr, lane); }
      } }
    const float* wo = inp(p, 14) + (size_t)l * 1024 * 1024; bf16_t* WOUT = (bf16_t*)(ws + WS_WOUT);
    const float* CF = (const float*)(ws + WS_CF) + (size_t)l * 2 * 65536;
    for (int it = obx(); it < 320; it += ogd()) {
        const int ti = it * 512 + tid, j = ti & 1023, kk0 = (ti >> 10) * 8, region = kk0 >> 8, kl = kk0 & 255;
        float acc[8];
#pragma unroll
        for (int e = 0; e < 8; ++e) acc[e] = 0.f;
        if (region == 0) { const int g = kl >> 6, c0 = kl & 63; const float* pw = inp(p, 15) + (((size_t)l * 4 + g) * 64 + c0) * 64; const float* ps = inp(p, 16) + (size_t)l * 256 + g * 64;
#pragma unroll 8
            for (int t = 0; t < 64; ++t) { const float wv = wo[(size_t)(g * 64 + t) * 1024 + j] * ps[t];
#pragma unroll
                for (int e = 0; e < 8; ++e) acc[e] += pw[e * 64 + t] * wv; }
        } else if (region <= 3) { const float* Lm = (region == 3 ? inp(p, 22) + (size_t)l * 65536 : CF + (size_t)(region - 1) * 65536) + (size_t)kl * 256;
            const float* wr = wo + (size_t)(region == 3 ? 512 : 256) * 1024 + j; const float sc = region == 3 ? 1.f : 0.125f;
#pragma unroll 8
            for (int t = 0; t < 256; ++t) { const float wv = wr[(size_t)t * 1024];
#pragma unroll
                for (int e = 0; e < 8; ++e) acc[e] += Lm[e * 256 + t] * wv; }
#pragma unroll
            for (int e = 0; e < 8; ++e) acc[e] *= sc;
        } else {
#pragma unroll
            for (int e = 0; e < 8; ++e) acc[e] = wo[(size_t)(768 + kl + e) * 1024 + j];
        }
        uint4 o; o.x = pk2(acc[0], acc[1]); o.y = pk2(acc[2], acc[3]); o.z = pk2(acc[4], acc[5]); o.w = pk2(acc[6], acc[7]);
        *(uint4*)(WOUT + (size_t)j * YK + kk0) = o;
    }
    { const int lane = tid & 63, wv = __builtin_amdgcn_readfirstlane(tid >> 6); float* sh_s = sm + 17000; float* red = sm + 26300;
      const float* MODL = (const float*)(ws + WS_MOD) + (size_t)l * 3 * 9216; float* BIAS = (float*)(ws + WS_BIAS);
      __syncthreads();
      for (int i = tid; i < 9216; i += 512) { const int use = i / 3072, mr = (i / 1024) % 3, k = i & 1023; sh_s[i] = MODL[(size_t)mr * 9216 + (3 * use) * 1024 + k]; }
      __syncthreads();
      for (int it = obx(); it < 209; it += ogd()) {
          int use, n, N, drow; const float* W;
          if (it < 176) { const int mat = it / 44, n0 = (it - mat * 44) * 64; use = (mat >> 1) * 2; N = FH; n = n0 + lane; W = inp(p, mat == 0 ? 7 : mat == 1 ? 8 : mat == 2 ? 10 : 11) + (size_t)l * 1024 * FH;
              drow = 256 * (n >> 7) + 128 * (mat & 1) + (n & 127); }
          else { use = 1; N = 2064; n = (it - 176) * 64 + lane; W = inp(p, 13) + (size_t)l * 1024 * 2064; drow = n; }
          float a0 = 0.f, a1 = 0.f, a2 = 0.f;
          if (n < N) { const float* wp = W + (size_t)(wv * 128) * N + n; const float* s0 = sh_s + use * 3072 + wv * 128;
#pragma unroll 8
              for (int k = 0; k < 128; ++k) { const float x = wp[(size_t)k * N]; a0 += s0[k] * x; a1 += s0[1024 + k] * x; a2 += s0[2048 + k] * x; } }
          red[(wv * 3 + 0) * 64 + lane] = a0; red[(wv * 3 + 1) * 64 + lane] = a1; red[(wv * 3 + 2) * 64 + lane] = a2;
          __syncthreads();
          if (tid < 192 && n < N) { const int r = tid >> 6; float sacc = 0.f;
#pragma unroll
              for (int w8 = 0; w8 < 8; ++w8) sacc += red[(w8 * 3 + r) * 64 + lane];
              BIAS[((size_t)use * 3 + r) * 5632 + drow] = sacc; }
          __syncthreads();
      }
      float* RS1 = (float*)(ws + WS_RS + RS_STRIDE);
      for (int i = obx() * 512 + tid; i < MROWS; i += ogd() * 512) RS1[i] = 0.f; }
    if (l == 0) raw_rows(p);
}

struct EpiUp {
    static constexpr bool PERM = true, AFTER_DRAIN = false; bf16_t* H; const float* rs; const float* bias;
    DEVI void operator()(const f32x4 (&acc)[2][2][4][2], const Unit& u, int wr, int wc, int fr, int fq) const {
        const int row0 = u.pm * 256 + wr * 64 + fr, col0 = u.pn * 128 + wc * 32 + 8 * fq; const int mr = u.pm < 64 ? 0 : (u.pm < 128 ? 1 : 2);
        const float* bp = bias + (size_t)mr * 5632 + u.pn * 256 + wc * 32 + 8 * fq;
        const f32x4 bg0 = *(const f32x4*)bp, bg1 = *(const f32x4*)(bp + 4), bu0 = *(const f32x4*)(bp + 128), bu1 = *(const f32x4*)(bp + 132);
        float rsl[2][4];
#pragma unroll
        for (int ai = 0; ai < 2; ++ai)
#pragma unroll
            for (int m = 0; m < 4; ++m) rsl[ai][m] = rs[row0 + ai * 128 + m * 16];
#pragma unroll
        for (int ai = 0; ai < 2; ++ai)
#pragma unroll
            for (int m = 0; m < 4; ++m) { const int row = row0 + ai * 128 + m * 16; bf16_t* rowp = H + (size_t)row * FH + col0;
                const float rv = rsqrtf(rsl[ai][m] * (1.f / 1024.f) + EPS);
                const f32x4 g0 = acc[ai][0][m][0] * rv + bg0, g1 = acc[ai][0][m][1] * rv + bg1, u0 = acc[ai][1][m][0] * rv + bu0, u1 = acc[ai][1][m][1] * rv + bu1;
                u32x4 w; w.x = pk2(siluf(g0[0]) * u0[0], siluf(g0[1]) * u0[1]); w.y = pk2(siluf(g0[2]) * u0[2], siluf(g0[3]) * u0[3]);
                w.z = pk2(siluf(g1[0]) * u1[0], siluf(g1[1]) * u1[1]); w.w = pk2(siluf(g1[2]) * u1[2], siluf(g1[3]) * u1[3]);
                *(u32x4*)rowp = w; }
    }
};
struct EpiRes {
    static constexpr bool PERM = true, AFTER_DRAIN = false; float* outx; float* ctxr; const float* inx; const float* gate; bf16_t* nyraw; float* rsacc; const float* nw; const float* nscale; float mult; int feeds;
    DEVI void operator()(const f32x4 (&acc)[2][2][4][2], const Unit& u, int wr, int wc, int fr, int fq) const {
        const int row0 = u.pm * 256 + wr * 64 + fr, col0 = u.pn * 256 + wc * 32 + 8 * fq; const int mr = u.pm < 64 ? 0 : (u.pm < 128 ? 1 : 2);
        float* base = (u.pm < 128 ? outx + (size_t)row0 * D : ctxr + (size_t)(row0 - T) * D) + col0;
        const float* rbase = (u.pm < 128 ? inx + (size_t)row0 * D : ctxr + (size_t)(row0 - T) * D) + col0;
        f32x4 gv[2][2], cw[2][2];
#pragma unroll
        for (int bj = 0; bj < 2; ++bj)
#pragma unroll
            for (int n = 0; n < 2; ++n) { gv[bj][n] = *(const f32x4*)(gate + (size_t)mr * 9216 + col0 + bj * 128 + n * 4) * mult;
                cw[bj][n] = *(const f32x4*)(nw + col0 + bj * 128 + n * 4) * (*(const f32x4*)(nscale + (size_t)mr * 9216 + col0 + bj * 128 + n * 4) + 1.f); }
        f32x4 rq[2][2][2];
#pragma unroll
        for (int k0 = 0; k0 < 1; ++k0) { const float* rr = rbase + (size_t)((k0 >> 2) * 128 + (k0 & 3) * 16) * D;
#pragma unroll
            for (int bj = 0; bj < 2; ++bj) { rq[k0][bj][0] = *(const f32x4*)(rr + bj * 128); rq[k0][bj][1] = *(const f32x4*)(rr + bj * 128 + 4); } }
#pragma unroll
        for (int k = 0; k < 8; ++k) { const int ai = k >> 2, m = k & 3; float* rowp = base + (size_t)(ai * 128 + m * 16) * D; const int row = row0 + ai * 128 + m * 16; float ss = 0.f;
            if (k + 1 < 8) { const float* rr = rbase + (size_t)(((k + 1) >> 2) * 128 + ((k + 1) & 3) * 16) * D;
#pragma unroll
                for (int bj = 0; bj < 2; ++bj) { rq[(k + 1) & 1][bj][0] = *(const f32x4*)(rr + bj * 128); rq[(k + 1) & 1][bj][1] = *(const f32x4*)(rr + bj * 128 + 4); } }
#pragma unroll
            for (int bj = 0; bj < 2; ++bj) { f32x4* pp = (f32x4*)(rowp + bj * 128);
                const f32x4 n0 = rq[k & 1][bj][0] + gv[bj][0] * acc[ai][bj][m][0], n1 = rq[k & 1][bj][1] + gv[bj][1] * acc[ai][bj][m][1]; pp[0] = n0; pp[1] = n1;
                if (feeds) { const f32x4 y0 = n0 * cw[bj][0], y1 = n1 * cw[bj][1]; u32x4 o; o.x = pk2(y0[0], y0[1]); o.y = pk2(y0[2], y0[3]); o.z = pk2(y1[0], y1[1]); o.w = pk2(y1[2], y1[3]);
                    *(u32x4*)(nyraw + (size_t)row * 1024 + col0 + bj * 128) = o;
                    ss += n0[0] * n0[0] + n0[1] * n0[1] + n0[2] * n0[2] + n0[3] * n0[3] + n1[0] * n1[0] + n1[1] * n1[1] + n1[2] * n1[2] + n1[3] * n1[3]; } }
            if (feeds) { ss += __shfl_xor(ss, 16); ss += __shfl_xor(ss, 32); if (fq == 0) atomicAdd(rsacc + row, ss); } }
    }
};
struct EpiP {
    static constexpr bool PERM = true, AFTER_DRAIN = false; bf16_t* P; const float* rs; const float* bias;
    DEVI void operator()(const f32x4 (&acc)[2][2][4][2], const Unit& u, int wr, int wc, int fr, int fq) const {
        const int row0 = u.pm * 256 + wr * 64 + fr, col0 = u.pn * 256 + wc * 32 + 8 * fq; const int mr = u.pm < 64 ? 0 : (u.pm < 128 ? 1 : 2);
        const float* bp = bias + (size_t)mr * 5632 + col0;
        f32x4 b0[2], b1[2];
#pragma unroll
        for (int bj = 0; bj < 2; ++bj) { b0[bj] = *(const f32x4*)(bp + bj * 128); b1[bj] = *(const f32x4*)(bp + bj * 128 + 4); }
        float rsl[2][4];
#pragma unroll
        for (int ai = 0; ai < 2; ++ai)
#pragma unroll
            for (int m = 0; m < 4; ++m) rsl[ai][m] = rs[row0 + ai * 128 + m * 16];
#pragma unroll
        for (int ai = 0; ai < 2; ++ai)
#pragma unroll
            for (int m = 0; m < 4; ++m) { const int row = row0 + ai * 128 + m * 16; bf16_t* rowp = P + (size_t)row * PPITCH + col0;
                const float rv = rsqrtf(rsl[ai][m] * (1.f / 1024.f) + EPS);
#pragma unroll
                for (int bj = 0; bj < 2; ++bj) if (col0 + bj * 128 < 2064) { const f32x4 v0 = acc[ai][bj][m][0] * rv + b0[bj], v1 = acc[ai][bj][m][1] * rv + b1[bj];
                    u32x4 w; w.x = pk2(v0[0], v0[1]); w.y = pk2(v0[2], v0[3]); w.z = pk2(v1[0], v1[1]); w.w = pk2(v1[2], v1[3]);
                    *(u32x4*)(rowp + bj * 128) = w; } }
    }
};

DEVI f32x4 mini_dot(const bf16_t* arow, const bf16_t* wrow, int K) {
    f32x4 c0 = (f32x4){0.f, 0.f, 0.f, 0.f}, c1 = c0;
#pragma unroll 1
    for (int k = 0; k < K; k += 256) {
        pg8::bf16x8 a[8], w[8];
#pragma unroll
        for (int q = 0; q < 8; ++q) { a[q] = *(const pg8::bf16x8*)(arow + k + 32 * q); w[q] = *(const pg8::bf16x8*)(wrow + k + 32 * q); }
#pragma unroll
        for (int q = 0; q < 8; q += 2) { c0 = __builtin_amdgcn_mfma_f32_16x16x32_bf16(w[q], a[q], c0, 0, 0, 0); c1 = __builtin_amdgcn_mfma_f32_16x16x32_bf16(w[q + 1], a[q + 1], c1, 0, 0, 0); }
    }
    return c0 + c1;
}
DEVI void mini_dot2(const bf16_t* arow, const bf16_t* w0row, const bf16_t* w1row, int K, f32x4& r0, f32x4& r1) {
    f32x4 c0 = (f32x4){0.f, 0.f, 0.f, 0.f}, c1 = c0;
#pragma unroll 1
    for (int k = 0; k < K; k += 256) {
        pg8::bf16x8 a[8], w[8], v[8];
#pragma unroll
        for (int q = 0; q < 8; ++q) { a[q] = *(const pg8::bf16x8*)(arow + k + 32 * q); w[q] = *(const pg8::bf16x8*)(w0row + k + 32 * q); v[q] = *(const pg8::bf16x8*)(w1row + k + 32 * q); }
#pragma unroll
        for (int q = 0; q < 8; ++q) { c0 = __builtin_amdgcn_mfma_f32_16x16x32_bf16(w[q], a[q], c0, 0, 0, 0); c1 = __builtin_amdgcn_mfma_f32_16x16x32_bf16(v[q], a[q], c1, 0, 0, 0); }
    }
    r0 = c0; r1 = c1;
}
DEVI void mini_up(const Params& p, const bf16_t* Wup) { unsigned char* const ws = opq(p.ws);
    const int tid = otid(), lane = tid & 63, fr = lane & 15, fq = lane >> 4;
    const bf16_t* NYp = (const bf16_t*)(ws + WS_NY); bf16_t* H = (bf16_t*)(ws + WS_H);
    for (int id = obx() * 8 + (tid >> 6); id < 32 * 176; id += ogd() * 8) {
        const int rt = id / 176, h0 = (id - rt * 176) * 16, g0 = 256 * (h0 >> 7) + (h0 & 127);
        const bf16_t* arow = NYp + (size_t)(T + 16 * rt + fr) * 1024 + fq * 8;
        f32x4 g, u; mini_dot2(arow, Wup + (size_t)(g0 + fr) * 1024 + fq * 8, Wup + (size_t)(g0 + 128 + fr) * 1024 + fq * 8, 1024, g, u);
        uint2 o; o.x = pk2(siluf(g[0]) * u[0], siluf(g[1]) * u[1]); o.y = pk2(siluf(g[2]) * u[2], siluf(g[3]) * u[3]);
        *(uint2*)(H + (size_t)(T + 16 * rt + fr) * FH + h0 + 4 * fq) = o;
    }
}
DEVI void mini_res(const Params& p, const bf16_t* A, const bf16_t* W, int K, const float* gate, float mult, bf16_t* nyraw, float* rsacc, const float* nw, const float* nscale, const float* Rin, float* sm) { unsigned char* const ws = opq(p.ws);
    const int tid = otid(), lane = tid & 63, wv = tid >> 6, fr = lane & 15, fq = lane >> 4;
    float* R = (float*)(ws + WS_CTXR);
    const int nsteps = K >> 8, kw = (K >> 3) * wv;
    for (int id = obx(); id < 32 * 8; id += ogd()) {
        const int rt = id >> 3, cg = id & 7;
        const bf16_t* arow = A + (size_t)(T + 16 * rt + fr) * K + kw + fq * 8; const bf16_t* wrow = W + (size_t)(128 * cg + fr) * K + kw + fq * 8;
        f32x4 acc[8];
#pragma unroll
        for (int t = 0; t < 8; ++t) acc[t] = (f32x4){0.f, 0.f, 0.f, 0.f};
#pragma unroll 1
        for (int s0 = 0; s0 < nsteps; s0 += 4) {
            pg8::bf16x8 av[4], wf[4][8];
#pragma unroll
            for (int j = 0; j < 4; ++j) { const int o = ((s0 + j) < nsteps ? (s0 + j) : nsteps - 1) * 32; av[j] = *(const pg8::bf16x8*)(arow + o);
#pragma unroll
                for (int t = 0; t < 8; ++t) wf[j][t] = *(const pg8::bf16x8*)(wrow + (size_t)(16 * t) * K + o); }
#pragma unroll
            for (int j = 0; j < 4; ++j) if (s0 + j < nsteps) {
#pragma unroll
                for (int t = 0; t < 8; ++t) acc[t] = __builtin_amdgcn_mfma_f32_16x16x32_bf16(wf[j][t], av[j], acc[t], 0, 0, 0); }
        }
#pragma unroll
        for (int t = 0; t < 8; ++t) *(f32x4*)(sm + ((wv * 8 + t) * 64 + lane) * 4) = acc[t];
        __syncthreads();
        f32x4 tot = (f32x4){0.f, 0.f, 0.f, 0.f};
#pragma unroll
        for (int w8 = 0; w8 < 8; ++w8) tot += *(const f32x4*)(sm + ((w8 * 8 + wv) * 64 + lane) * 4);
        const int row = 16 * rt + fr, col = 128 * cg + 16 * wv + 4 * fq;
        const f32x4 gv = *(const f32x4*)(gate + 2 * 9216 + col) * mult;
        f32x4* pp = (f32x4*)(R + (size_t)row * D + col); const f32x4 nv = *(const f32x4*)(Rin + (size_t)row * D + col) + gv * tot; *pp = nv;
        if (nyraw) { const f32x4 y = nv * (*(const f32x4*)(nw + col) * (*(const f32x4*)(nscale + 2 * 9216 + col) + 1.f));
            uint2 o; o.x = pk2(y[0], y[1]); o.y = pk2(y[2], y[3]); *(uint2*)(nyraw + (size_t)(T + row) * 1024 + col) = o;
            float ss = nv[0] * nv[0] + nv[1] * nv[1] + nv[2] * nv[2] + nv[3] * nv[3]; ss += __shfl_xor(ss, 16); ss += __shfl_xor(ss, 32);
            if (fq == 0) atomicAdd(rsacc + T + row, ss); }
        __syncthreads();
    }
}
DEVI void mini_in(const Params& p) { unsigned char* const ws = opq(p.ws);
    const int tid = otid(), lane = tid & 63, fr = lane & 15, fq = lane >> 4;
    const bf16_t* NYp = (const bf16_t*)(ws + WS_NY); const bf16_t* W = (const bf16_t*)(ws + WS_WIN); bf16_t* P = (bf16_t*)(ws + WS_P);
    for (int id = obx() * 8 + (tid >> 6); id < 32 * 129 + 2048; id += ogd() * 8) {
        int row0, n0;
        if (id < 32 * 129) { const int rt = id / 129; row0 = T + 16 * rt; n0 = (id - rt * 129) * 16; } else { row0 = (id - 32 * 129) * 16; n0 = 2048; }
        const f32x4 acc = mini_dot(NYp + (size_t)(row0 + fr) * 1024 + fq * 8, W + (size_t)(n0 + fr) * 1024 + fq * 8, 1024);
        uint2 o; o.x = pk2(acc[0], acc[1]); o.y = pk2(acc[2], acc[3]);
        *(uint2*)(P + (size_t)(row0 + fr) * PPITCH + n0 + 4 * fq) = o;
    }
}

DEVI float dpp_xor1(float v) { return __int_as_float(__builtin_amdgcn_update_dpp(0, __float_as_int(v), 0xB1, 0xF, 0xF, true)); }
DEVI float dpp_xor2(float v) { return __int_as_float(__builtin_amdgcn_update_dpp(0, __float_as_int(v), 0x4E, 0xF, 0xF, true)); }
constexpr int CW_OFF = 28672;
struct G1Raw { uint4 v0[3], v1[3], v2[3]; unsigned ab; };
DEVI void g1_decode(int item, int tid, int& chain, int& ci, int& dir, int& h, int& seqbase, int& len, int& jj) {
    chain = item / NCH; ci = item - chain * NCH;
    const int b = chain >> 3; dir = (chain >> 2) & 1; h = chain & 3;
    int j, nc;
    if (ci < 4) { seqbase = T + b * 256; len = 256; j = ci; nc = 4; } else { seqbase = b * SEQ; len = SEQ; j = ci - 4; nc = 256; }
    jj = dir ? nc - 1 - j : j;
}
DEVI void g1_load(const Params& p, int item, G1Raw& raw) { unsigned char* const ws = opq(p.ws);
    const int tid = otid(); int chain, ci, dir, h, seqbase, len, jj; g1_decode(item, tid, chain, ci, dir, h, seqbase, len, jj);
    const bf16_t* P = (const bf16_t*)(ws + WS_P);
    const int r = tid >> 3, d8 = (tid & 7) * 8;
    const int pos = dir ? 64 * jj + 63 - r : 64 * jj + r, posL = pos > 0 ? pos - 1 : 0, posR = pos < len - 1 ? pos + 1 : len - 1;
    const bf16_t* pr = P + (size_t)(seqbase + pos) * PPITCH; const bf16_t* pl = P + (size_t)(seqbase + posL) * PPITCH; const bf16_t* pq = P + (size_t)(seqbase + posR) * PPITCH;
#pragma unroll
    for (int w3 = 0; w3 < 3; ++w3) { const int cb = 1024 + w3 * 256 + h * 64 + d8;
        raw.v1[w3] = *(const uint4*)(pr + cb); raw.v0[w3] = *(const uint4*)(pl + cb); raw.v2[w3] = *(const uint4*)(pq + cb); }
    const int hd = dir * 4 + h;
    raw.ab = (unsigned)pr[2048 + hd] | ((unsigned)pr[2056 + hd] << 16);
}
DEVI void g1_item(const Params& p, int l, int item, int next_item, G1Raw& raw, float* sm) { unsigned char* const ws = opq(p.ws);
    const int tid = otid(), lane = tid & 63, wv = tid >> 6;
    int chain, ci, dir, h, seqbase, len, jj; g1_decode(item, tid, chain, ci, dir, h, seqbase, len, jj);
    bf16_t* q_b = (bf16_t*)sm; bf16_t* k_b = q_b + 4608; bf16_t* kdT_b = q_b + 9216; bf16_t* aqk_b = q_b + 13824; bf16_t* XT_b = q_b + 18432;
    float* Mp = sm + 13824;
    float* X_s = sm + 18176;
    float* gc_s = sm + 26624; float* be_s = gc_s + 64; float* eg_s = gc_s + 128; float* kd_s = gc_s + 192; float* gt_s = gc_s + 256; float* misc = gc_s + 320;
    float kf[8];
    {
        const int r = tid >> 3, d8 = (tid & 7) * 8;
        const int pos = dir ? 64 * jj + 63 - r : 64 * jj + r;
        const bool hasL = pos > 0, hasR = pos < len - 1;
        const float* cw = sm + CW_OFF;
        float val[3][8];
#pragma unroll
        for (int w3 = 0; w3 < 3; ++w3) {
            const int cb = w3 * 256 + h * 64 + d8;
            const uint4 z = make_uint4(0u, 0u, 0u, 0u);
            const uint4 v1 = raw.v1[w3];
            const uint4 v0 = hasL ? raw.v0[w3] : z;
            const uint4 v2 = hasR ? raw.v2[w3] : z;
            float x0[8], x1[8], x2[8]; UNPACK8(v0, x0); UNPACK8(v1, x1); UNPACK8(v2, x2);
#pragma unroll
            for (int e = 0; e < 8; ++e) val[w3][e] = siluf(x0[e] * cw[cb + e] + x1[e] * cw[768 + cb + e] + x2[e] * cw[1536 + cb + e]);
        }
        const unsigned ab = raw.ab;
        if (next_item >= 0) g1_load(p, next_item, raw);
        float sq = 0.f, sk = 0.f;
#pragma unroll
        for (int e = 0; e < 8; ++e) { sq += val[0][e] * val[0][e]; sk += val[1][e] * val[1][e]; }
        sq += __shfl_xor(sq, 1); sq += __shfl_xor(sq, 2); sq += __shfl_xor(sq, 4);
        sk += __shfl_xor(sk, 1); sk += __shfl_xor(sk, 2); sk += __shfl_xor(sk, 4);
        const float qs = rsqrtf(sq + EPS) * 0.125f, ks = rsqrtf(sk + EPS);
        const int hd = dir * 4 + h;
        const float av = __uint_as_float(ab << 16), bv = __uint_as_float(ab & 0xFFFF0000u);
        const float beta = sigmf(bv);
        const float xa = av + inp(p, 25)[l * 8 + hd];
        const float sp = xa > 20.f ? xa : log1pf(__expf(xa));
        const float g = -__expf(inp(p, 24)[l * 8 + hd]) * sp;
#pragma unroll
        for (int e = 0; e < 8; ++e) kf[e] = val[1][e] * ks;
        uint4 o; o.x = pk2(val[0][0] * qs, val[0][1] * qs); o.y = pk2(val[0][2] * qs, val[0][3] * qs); o.z = pk2(val[0][4] * qs, val[0][5] * qs); o.w = pk2(val[0][6] * qs, val[0][7] * qs);
        *(uint4*)(q_b + r * 72 + d8) = o;
        o.x = pk2(kf[0], kf[1]); o.y = pk2(kf[2], kf[3]); o.z = pk2(kf[4], kf[5]); o.w = pk2(kf[6], kf[7]);
        *(uint4*)(k_b + r * 72 + d8) = o;
        *(float4*)(X_s + r * 132 + d8) = make_float4(val[2][0] * beta, val[2][1] * beta, val[2][2] * beta, val[2][3] * beta);
        *(float4*)(X_s + r * 132 + d8 + 4) = make_float4(val[2][4] * beta, val[2][5] * beta, val[2][6] * beta, val[2][7] * beta);
        if ((tid & 7) == 0) { gt_s[r] = g; be_s[r] = beta; }
    }
    __syncthreads();
    { float v = gt_s[lane];
#pragma unroll
        for (int o = 1; o < 64; o <<= 1) { const float t = __shfl_up(v, o); if (lane >= o) v += t; }
        const float gl = __shfl(v, 63); gc_s[lane] = v; eg_s[lane] = __expf(v); kd_s[lane] = __expf(gl - v); if (lane == 63) misc[0] = __expf(gl); }
    { const int r = tid >> 3, d8 = (tid & 7) * 8; const float f = be_s[r] * eg_s[r], kdr = kd_s[r];
        *(float4*)(X_s + r * 132 + 64 + d8) = make_float4(kf[0] * f, kf[1] * f, kf[2] * f, kf[3] * f);
        *(float4*)(X_s + r * 132 + 64 + d8 + 4) = make_float4(kf[4] * f, kf[5] * f, kf[6] * f, kf[7] * f);
#pragma unroll
        for (int e = 0; e < 8; ++e) kdT_b[(d8 + e) * 72 + ((((r >> 3) ^ (tid & 7)) << 3) | (r & 7))] = f2bf(kf[e] * kdr); }
    {
        const int isQ = wv >> 2, ti = wv & 3, fr = lane & 15, fq = lane >> 4;
        const bf16_t* Lb = isQ ? q_b : k_b;
        const pg8::bf16x8 a0 = *(const pg8::bf16x8*)(Lb + (16 * ti + fr) * 72 + fq * 8), a1 = *(const pg8::bf16x8*)(Lb + (16 * ti + fr) * 72 + fq * 8 + 32);
        for (int tj = 0; tj < 4; ++tj) {
            f32x4 acc = (f32x4){0.f, 0.f, 0.f, 0.f};
            if (tj <= ti) {
                const pg8::bf16x8 b0 = *(const pg8::bf16x8*)(k_b + (16 * tj + fr) * 72 + fq * 8), b1 = *(const pg8::bf16x8*)(k_b + (16 * tj + fr) * 72 + fq * 8 + 32);
                acc = __builtin_amdgcn_mfma_f32_16x16x32_bf16(a0, b0, acc, 0, 0, 0);
                acc = __builtin_amdgcn_mfma_f32_16x16x32_bf16(a1, b1, acc, 0, 0, 0);
            }
            const int jn = 16 * tj + fr; const float gj = gc_s[jn];
#pragma unroll
            for (int rg = 0; rg < 4; ++rg) { const int i = 16 * ti + fq * 4 + rg;
                const float dec = i >= jn ? __expf(gc_s[i] - gj) : 0.f;
                if (!isQ) { if (tj <= ti) Mp[i * 68 + (jn & 3) * 16 + (jn >> 2)] = (i > jn) ? be_s[i] * acc[rg] * dec : 0.f; }
                else aqk_b[i * 72 + jn] = (i >= jn) ? f2bf(acc[rg] * dec) : (bf16_t)0; }
        }
    }
    float* Td = gc_s + 384;
    if (wv < 4) {
        const int I = wv, cq = lane >> 2, pp = lane & 3;
        float xr[4] = {0.f, 0.f, 0.f, 0.f}, mb[16][4];
#pragma unroll
        for (int r = 0; r < 16; ++r) { const float4 m4 = *(const float4*)(Mp + (16 * I + r) * 68 + pp * 16 + 4 * I); mb[r][0] = m4.x; mb[r][1] = m4.y; mb[r][2] = m4.z; mb[r][3] = m4.w; }
#pragma unroll
        for (int r = 0; r < 16; ++r) { float part = 0.f;
#pragma unroll
            for (int q = 0; q < (r + 3) / 4; ++q) part += mb[r][q] * xr[q];
            part += dpp_xor1(part); part += dpp_xor2(part);
            const float ti = (r == cq ? 1.f : 0.f) - part;
            if (pp == (r & 3)) xr[r >> 2] = ti; }
#pragma unroll
        for (int q = 0; q < 4; ++q) Td[I * 256 + (4 * q + pp) * 16 + cq] = xr[q];
    }
    __syncthreads();
    {
        const int fr = lane & 15, fq = lane >> 4, c = 16 * wv + fr;
        f32x4 R[4];
#pragma unroll
        for (int I = 0; I < 4; ++I)
#pragma unroll
            for (int rg = 0; rg < 4; ++rg) R[I][rg] = X_s[(16 * I + 4 * fq + rg) * 132 + c];
#pragma unroll
        for (int I = 0; I < 4; ++I) {
            f32x4 x = (f32x4){0.f, 0.f, 0.f, 0.f};
#pragma unroll
            for (int kk = 0; kk < 4; ++kk) x = __builtin_amdgcn_mfma_f32_16x16x4f32(Td[I * 256 + fr * 16 + 4 * fq + kk], R[I][kk], x, 0, 0, 0);
#pragma unroll
            for (int I2 = I + 1; I2 < 4; ++I2)
#pragma unroll
                for (int kk = 0; kk < 4; ++kk) R[I2] = __builtin_amdgcn_mfma_f32_16x16x4f32(-Mp[(16 * I2 + fr) * 68 + kk * 16 + 4 * I + fq], x[kk], R[I2], 0, 0, 0);
            uint2 o; o.x = pk2(x[0], x[1]); o.y = pk2(x[2], x[3]);
            *(uint2*)(XT_b + c * 72 + 16 * I + 4 * fq) = o;
        }
    }
    __syncthreads();
    {
        const int fr = lane & 15, fq = lane >> 4, c = 16 * wv + fr;
        const pg8::bf16x8 b0 = *(const pg8::bf16x8*)(XT_b + c * 72 + fq * 8), b1 = *(const pg8::bf16x8*)(XT_b + c * 72 + fq * 8 + 32);
        const float egl = misc[0];
        float* rec = (float*)(ws + WS_GD) + (size_t)(chain * NCH + ci) * GD_REC_F;
        bf16_t* Qp = (bf16_t*)(rec + 8192); bf16_t* Op = Qp + 4096;
#pragma unroll
        for (int rt = 0; rt < 4; ++rt) {
            const int kg = (2 * rt + (fr >> 3)) & 7;
            const pg8::bf16x8 k0 = *(const pg8::bf16x8*)(kdT_b + (16 * rt + fr) * 72 + ((fq ^ kg) << 3)), k1 = *(const pg8::bf16x8*)(kdT_b + (16 * rt + fr) * 72 + (((fq + 4) ^ kg) << 3));
            const pg8::bf16x8 q0 = *(const pg8::bf16x8*)(aqk_b + (16 * rt + fr) * 72 + fq * 8), q1 = *(const pg8::bf16x8*)(aqk_b + (16 * rt + fr) * 72 + fq * 8 + 32);
            f32x4 a1 = (f32x4){0.f, 0.f, 0.f, 0.f}, a2 = (f32x4){0.f, 0.f, 0.f, 0.f};
            a1 = __builtin_amdgcn_mfma_f32_16x16x32_bf16(k0, b0, a1, 0, 0, 0); a1 = __builtin_amdgcn_mfma_f32_16x16x32_bf16(k1, b1, a1, 0, 0, 0);
            a2 = __builtin_amdgcn_mfma_f32_16x16x32_bf16(q0, b0, a2, 0, 0, 0); a2 = __builtin_amdgcn_mfma_f32_16x16x32_bf16(q1, b1, a2, 0, 0, 0);
            if (wv < 4) *(f32x4*)(rec + 4096 + ((wv * 4 + rt) * 64 + lane) * 4) = a1;
#pragma unroll
            for (int rg = 0; rg < 4; ++rg) { const int d1 = 16 * rt + fq * 4 + rg;
                if (wv < 4) { Op[d1 * 64 + c] = f2bf(a2[rg]); }
                else { const int cc = c - 64; rec[(((d1 >> 4) * 4 + (cc >> 4)) * 64 + (cc & 3) * 16 + (d1 & 15)) * 4 + ((cc >> 2) & 3)] = (d1 == cc ? egl : 0.f) - a1[rg]; Qp[d1 * 64 + cc] = f2bf(bf2f(q_b[d1 * 72 + cc]) * eg_s[d1] - a2[rg]); } }
        }
    }
    __syncthreads();
}

template <int LOGN, int LOGCH>
DEVI void fft_lds(float2* X, const float2* tw) {
    const int tid = otid(); constexpr int CH = 1 << LOGCH;
#pragma unroll 1
    for (int s = 1; s <= LOGN; ++s) {
        const int half = 1 << (s - 1);
#pragma unroll
        for (int i = 0; i < 8; ++i) {
            const int bi = tid + 512 * i, ch = bi & (CH - 1), bf = bi >> LOGCH;
            const int jx = bf & (half - 1), grp = bf >> (s - 1);
            const int i0 = (grp << s) + jx, i1 = i0 + half;
            const float2 w = tw[jx << (LOGN - s)];
            const float2 a = X[i0 * CH + ch], bq = X[i1 * CH + ch];
            const float2 t = make_float2(w.x * bq.x - w.y * bq.y, w.x * bq.y + w.y * bq.x);
            X[i0 * CH + ch] = make_float2(a.x + t.x, a.y + t.y); X[i1 * CH + ch] = make_float2(a.x - t.x, a.y - t.y);
        }
        __syncthreads();
    }
}
DEVI void fft128_lds(float2* X, const float2* tw) { fft_lds<7, 6>(X, tw); }
DEVI void trig_tables(float* sm) {
    const int tid = otid();
    if (tid < 64) { float s, c; sincospif((float)tid * (1.f / 64.f), &s, &c); ((float2*)(sm + TAB_OFF))[tid] = make_float2(c, -s); }
    if (tid < 128) { float s, c; sincospif((float)tid * (1.f / 128.f), &s, &c); ((float2*)(sm + TAB_OFF + 128))[tid] = make_float2(c, -s); }
    __syncthreads();
}
DEVI void fft1_item(const Params& p, int item, float* sm) { unsigned char* const ws = opq(p.ws);
    const int tid = otid(); const int cb = item & 3, bb = (item >> 2) & 127, b = item >> 9;
    const bf16_t* P = (const bf16_t*)(ws + WS_P); float2* X = (float2*)sm; const float2* tw = (const float2*)(sm + TAB_OFF);
#pragma unroll
    for (int i = 0; i < 2; ++i) { const int ti = tid + 512 * i, a = ti >> 3, c8 = ti & 7;
        const uint4 v = *(const uint4*)(P + (size_t)(b * SEQ + 128 * a + bb) * PPITCH + 256 + cb * 64 + c8 * 8);
        float f[8]; UNPACK8(v, f); const int ra = (int)(__brev((unsigned)a) >> 25);
#pragma unroll
        for (int e = 0; e < 8; ++e) X[ra * 64 + c8 * 8 + e] = make_float2(f[e], 0.f); }
    __syncthreads();
    fft128_lds(X, tw);
    float2* FS = (float2*)(ws + WS_FS);
    float s, co, ss, cs; sincospif((float)(bb * (tid >> 6)) * (-2.f / 16384.f), &s, &co); sincospif((float)(bb * 8) * (-2.f / 16384.f), &ss, &cs);
#pragma unroll 4
    for (int i = 0; i < 16; ++i) { const int ti = tid + 512 * i, ch = ti & 63, c = ti >> 6;
        const float2 v = X[c * 64 + ch];
        FS[((size_t)(b * 128 + c) * 128 + bb) * 256 + cb * 64 + ch] = make_float2(v.x * co - v.y * s, v.x * s + v.y * co);
        const float nc = co * cs - s * ss, ns = co * ss + s * cs; co = nc; s = ns; }
    __syncthreads();
}
DEVI void fft2_item(const Params& p, int item, float* sm) { unsigned char* const ws = opq(p.ws);
    const int tid = otid(); const int cb = item & 3, c = (item >> 2) & 127, b = item >> 9;
    float2* X = (float2*)sm; const float2* tw = (const float2*)(sm + TAB_OFF);
    const float2* FS = (const float2*)(ws + WS_FS) + (size_t)(b * 128 + c) * 128 * 256 + cb * 64;
#pragma unroll 4
    for (int i = 0; i < 16; ++i) { const int ti = tid + 512 * i, ch = ti & 63, bb = ti >> 6;
        X[(int)(__brev((unsigned)bb) >> 25) * 64 + ch] = FS[(size_t)bb * 256 + ch]; }
    __syncthreads();
    fft128_lds(X, tw);
    bf16_t* Y = (bf16_t*)(ws + WS_NY);
#pragma unroll
    for (int i = 0; i < 2; ++i) { const int ti = tid + 512 * i, d = ti >> 3, c8 = ti & 7;
        float re[8], im[8];
#pragma unroll
        for (int e = 0; e < 8; ++e) { const float2 v = X[d * 64 + c8 * 8 + e]; re[e] = v.x * (1.f / 128.f); im[e] = v.y * (1.f / 128.f); }
        bf16_t* yr = Y + (size_t)(b * SEQ + c + 128 * d) * YK + 256 + cb * 64 + c8 * 8;
        uint4 o; o.x = pk2(re[0], re[1]); o.y = pk2(re[2], re[3]); o.z = pk2(re[4], re[5]); o.w = pk2(re[6], re[7]); *(uint4*)yr = o;
        o.x = pk2(im[0], im[1]); o.y = pk2(im[2], im[3]); o.z = pk2(im[4], im[5]); o.w = pk2(im[6], im[7]); *(uint4*)(yr + 256) = o; }
    __syncthreads();
}
DEVI void ctxfft_item(const Params& p, int item, float* sm) { unsigned char* const ws = opq(p.ws);
    const int tid = otid(); const int cb = item & 7, b = item >> 3;
    const bf16_t* P = (const bf16_t*)(ws + WS_P); float2* X = (float2*)sm; const float2* tw = (const float2*)(sm + TAB_OFF + 128);
#pragma unroll
    for (int i = 0; i < 2; ++i) { const int ti = tid + 512 * i, n = ti >> 2, c8 = ti & 3;
        const uint4 v = *(const uint4*)(P + (size_t)(T + b * 256 + n) * PPITCH + 256 + cb * 32 + c8 * 8);
        float f[8]; UNPACK8(v, f); const int rn = (int)(__brev((unsigned)n) >> 24);
#pragma unroll
        for (int e = 0; e < 8; ++e) X[rn * 32 + c8 * 8 + e] = make_float2(f[e], 0.f); }
    __syncthreads();
    fft_lds<8, 5>(X, tw);
    bf16_t* Y = (bf16_t*)(ws + WS_NY);
#pragma unroll
    for (int i = 0; i < 2; ++i) { const int ti = tid + 512 * i, k = ti >> 2, c8 = ti & 3;
        float re[8], im[8];
#pragma unroll
        for (int e = 0; e < 8; ++e) { const float2 v = X[k * 32 + c8 * 8 + e]; re[e] = v.x * (1.f / 16.f); im[e] = v.y * (1.f / 16.f); }
        bf16_t* yr = Y + (size_t)(T + b * 256 + k) * YK + 256 + cb * 32 + c8 * 8;
        uint4 o; o.x = pk2(re[0], re[1]); o.y = pk2(re[2], re[3]); o.z = pk2(re[4], re[5]); o.w = pk2(re[6], re[7]); *(uint4*)yr = o;
        o.x = pk2(im[0], im[1]); o.y = pk2(im[2], im[3]); o.z = pk2(im[4], im[5]); o.w = pk2(im[6], im[7]); *(uint4*)(yr + 256) = o; }
    __syncthreads();
}
DEVI void conv_item(const Params& p, int l, int item, float* sm) { unsigned char* const ws = opq(p.ws);
    const int tid = otid(), lane = tid & 63, wv = tid >> 6;
    int base, len, tile;
    if (item < 1024) { base = (item >> 9) * SEQ; len = SEQ; tile = item & 511; } else { const int cj = item - 1024; base = T + (cj >> 3) * 256; len = 256; tile = cj & 7; }
    const int t0 = tile * 32;
    const bf16_t* P = (const bf16_t*)(ws + WS_P);
    float* glu = sm;
    float* hb = sm + 62 * 256;
    for (int ti = tid; ti < 62 * 32; ti += 512) { const int pp = ti >> 5, c8 = ti & 31, pos = t0 - 15 + pp;
        float o[8];
        if (pos >= 0 && pos < len) { const bf16_t* pr = P + (size_t)(base + pos) * PPITCH + 512 + c8 * 8;
            const uint4 va = *(const uint4*)pr, vb = *(const uint4*)(pr + 256); float fa[8], fb[8]; UNPACK8(va, fa); UNPACK8(vb, fb);
#pragma unroll
            for (int e = 0; e < 8; ++e) o[e] = fa[e] * sigmf(fb[e]);
        } else {
#pragma unroll
            for (int e = 0; e < 8; ++e) o[e] = 0.f; }
        *(float4*)(glu + pp * 256 + c8 * 8) = make_float4(o[0], o[1], o[2], o[3]); *(float4*)(glu + pp * 256 + c8 * 8 + 4) = make_float4(o[4], o[5], o[6], o[7]); }
    __syncthreads();
    { const int ch = tid & 255, half = tid >> 8; const float* w = inp(p, 18) + (size_t)l * 31 * 256 + ch; const float bias = inp(p, 19)[l * 256 + ch];
        float wr[31];
#pragma unroll
        for (int jx = 0; jx < 31; ++jx) wr[jx] = w[jx * 256];
        float win[46];
#pragma unroll
        for (int jx = 0; jx < 46; ++jx) win[jx] = glu[(half * 16 + jx) * 256 + ch];
#pragma unroll
        for (int pi = 0; pi < 16; ++pi) { float h = bias;
#pragma unroll
            for (int jx = 0; jx < 31; ++jx) h += win[pi + jx] * wr[jx];
            hb[(half * 16 + pi) * 256 + ch] = h; } }
    __syncthreads();
    { const float4 g4 = *(const float4*)(inp(p, 20) + l * 256 + lane * 4), b4 = *(const float4*)(inp(p, 21) + l * 256 + lane * 4);
        bf16_t* Y = (bf16_t*)(ws + WS_NY);
#pragma unroll
        for (int qi = 0; qi < 4; ++qi) { const int q = wv * 4 + qi; const float4 h4 = *(const float4*)(hb + q * 256 + lane * 4);
            const float mu = wave_sum(h4.x + h4.y + h4.z + h4.w) * (1.f / 256.f);
            const float dx = h4.x - mu, dy = h4.y - mu, dz = h4.z - mu, dw = h4.w - mu;
            const float var = wave_sum(dx * dx + dy * dy + dz * dz + dw * dw) * (1.f / 256.f); const float rs = rsqrtf(var + EPS);
            uint2 o; o.x = pk2(siluf(dx * rs * g4.x + b4.x), siluf(dy * rs * g4.y + b4.y)); o.y = pk2(siluf(dz * rs * g4.z + b4.z), siluf(dw * rs * g4.w + b4.w));
            *(uint2*)(Y + (size_t)(base + t0 + q) * YK + 768 + lane * 4) = o; } }
    __syncthreads();
}
DEVI void poolx_item(const Params& p, int item, float* sm) { unsigned char* const ws = opq(p.ws);
    const int tid = otid(); const int g = item & 3, r0 = ((item >> 2) & 31) * 8, b = item >> 7, w = 2 << g, hw = w >> 1;
    const int c = tid >> 3, c8 = tid & 7, ch0 = g * 64 + c8 * 8;
    const bf16_t* P = (const bf16_t*)(ws + WS_P) + (size_t)b * SEQ * PPITCH + (size_t)c * PPITCH + ch0;
    bf16_t* Y = (bf16_t*)(ws + WS_NY) + (size_t)b * SEQ * YK + (size_t)c * YK + ch0;
    float* Vs = sm;
#define ADD8(A, B, v, sgn) do { (A).x += (sgn) * __uint_as_float((v).x << 16); (A).y += (sgn) * __uint_as_float((v).x & 0xFFFF0000u); (A).z += (sgn) * __uint_as_float((v).y << 16); (A).w += (sgn) * __uint_as_float((v).y & 0xFFFF0000u); \
        (B).x += (sgn) * __uint_as_float((v).z << 16); (B).y += (sgn) * __uint_as_float((v).z & 0xFFFF0000u); (B).z += (sgn) * __uint_as_float((v).w << 16); (B).w += (sgn) * __uint_as_float((v).w & 0xFFFF0000u); } while (0)
    float4 V0 = make_float4(0.f, 0.f, 0.f, 0.f), V1 = V0;
    { const int lo = max(r0 - hw, 0), hi = min(r0 + w - hw, 256);
#pragma unroll
      for (int rr = 0; rr < 16; ++rr) { const int r = lo + rr; if (r < hi) { const uint4 v = *(const uint4*)(P + (size_t)r * 64 * PPITCH); ADD8(V0, V1, v, 1.f); } } }
    const int c0 = max(c - hw, 0), c1 = min(c + w - hw, 64);
#pragma unroll 1
    for (int i = 0; i < 8; ++i) { const int r = r0 + i, radd = r + w - hw, rsub = r - hw;
        *(float4*)(Vs + c * 64 + c8 * 8) = V0; *(float4*)(Vs + c * 64 + c8 * 8 + 4) = V1;
        const uint4 z = make_uint4(0u, 0u, 0u, 0u);
        uint4 va = *(const uint4*)(P + (size_t)min(radd, 255) * 64 * PPITCH), vs = *(const uint4*)(P + (size_t)max(rsub, 0) * 64 * PPITCH); const uint4 uv = *(const uint4*)(P + (size_t)r * 64 * PPITCH);
        if (radd >= 256) va = z; if (rsub < 0) vs = z;
        __syncthreads();
        float4 s0 = make_float4(0.f, 0.f, 0.f, 0.f), s1 = s0;
        for (int cc = c0; cc < c1; ++cc) { const float4 x = *(const float4*)(Vs + cc * 64 + c8 * 8), y = *(const float4*)(Vs + cc * 64 + c8 * 8 + 4);
            s0.x += x.x; s0.y += x.y; s0.z += x.z; s0.w += x.w; s1.x += y.x; s1.y += y.y; s1.z += y.z; s1.w += y.w; }
        const float inv = 1.f / (float)((min(radd, 256) - max(rsub, 0)) * (c1 - c0));
        float4 u0 = make_float4(0.f, 0.f, 0.f, 0.f), u1 = u0; ADD8(u0, u1, uv, 1.f);
        uint4 o; o.x = pk2(s0.x * inv - u0.x, s0.y * inv - u0.y); o.y = pk2(s0.z * inv - u0.z, s0.w * inv - u0.w); o.z = pk2(s1.x * inv - u1.x, s1.y * inv - u1.y); o.w = pk2(s1.z * inv - u1.z, s1.w * inv - u1.w);
        *(uint4*)(Y + (size_t)r * 64 * YK) = o;
        ADD8(V0, V1, va, 1.f); ADD8(V0, V1, vs, -1.f);
        __syncthreads();
    }
#undef ADD8
}
DEVI void poolc_item(const Params& p, int item) { unsigned char* const ws = opq(p.ws);
    const int tid = otid(); const bf16_t* P = (const bf16_t*)(ws + WS_P); bf16_t* Y = (bf16_t*)(ws + WS_NY);
    const int b = item >> 4, c8 = tid & 31, n = (item & 15) * 16 + (tid >> 5), w = 2 << (c8 >> 3);
    const int lo = max(n - w / 2, 0), hi = min(n + w - w / 2, 256);
    float s[8];
#pragma unroll
    for (int e = 0; e < 8; ++e) s[e] = 0.f;
#pragma unroll
    for (int rr = 0; rr < 16; ++rr) { const int r = lo + rr; if (r < hi) { const uint4 v = *(const uint4*)(P + (size_t)(T + b * 256 + r) * PPITCH + c8 * 8); float f[8]; UNPACK8(v, f);
#pragma unroll
        for (int e = 0; e < 8; ++e) s[e] += f[e]; } }
    const float inv = 1.f / (float)(hi - lo); const size_t row = (size_t)(T + b * 256 + n);
    const uint4 uv = *(const uint4*)(P + row * PPITCH + c8 * 8); float u[8]; UNPACK8(uv, u);
    uint4 o; o.x = pk2(s[0] * inv - u[0], s[1] * inv - u[1]); o.y = pk2(s[2] * inv - u[2], s[3] * inv - u[3]); o.z = pk2(s[4] * inv - u[4], s[5] * inv - u[5]); o.w = pk2(s[6] * inv - u[6], s[7] * inv - u[7]);
    *(uint4*)(Y + row * YK + c8 * 8) = o;
}
#ifndef M2_CONV
#define M2_CONV 0
#define M2_POOL 1
#endif
DEVI void phase_m1(const Params& p, int l, float* sm) {
    trig_tables(sm);
    constexpr int N_G1 = 16 * NCH, N_F1 = 1024, N_CV = 1040, N_PX = 256, N_CF = 16, N_PC = 32;
    const int G = ogd(), bx = obx();
    { const float* cwg = inp(p, 23) + (size_t)l * 3 * 768; for (int i = otid(); i < 2304; i += 512) sm[CW_OFF + i] = cwg[i]; }
    __syncthreads();
    { G1Raw raw; int it = bx; if (it < N_G1) g1_load(p, it, raw);
      for (; it < N_G1; it += G) g1_item(p, l, it, it + G < N_G1 ? it + G : -1, raw, sm); }
    for (int it = (bx + 192) % G; it < N_F1; it += G) fft1_item(p, it, sm);
    if (!M2_CONV) for (int it = (bx + 176) % G; it < N_CV; it += G) conv_item(p, l, it, sm);
    if (!M2_POOL) { for (int it = bx; it < N_PX; it += G) poolx_item(p, it, sm);
        for (int it = (bx + 128) % G; it < N_CF; it += G) ctxfft_item(p, it, sm);
        for (int it = (bx + 96) % G; it < N_PC; it += G) poolc_item(p, it); }
}

DEVI void scan_block(const Params& p, int sb, float* sm) { unsigned char* const ws = opq(p.ws);
    const int tid = otid(), lane = tid & 63, wv = tid >> 6, chain = sb >> 2, slice = sb & 3;
    const int rt = wv & 3, fr = lane & 15, fq = lane >> 4; const bool act = wv < 4;
    float* Sl = sm;
    float* base = (float*)(ws + WS_GD) + (size_t)chain * NCH * GD_REC_F;
    const int aoff = (rt * 4 * 64 + lane) * 4, boff = 4096 + ((slice * 4 + rt) * 64 + lane) * 4;
    float zz = 0.f; asm volatile("" : "+v"(zz));
    f32x4 sreg = (f32x4){zz, zz, zz, zz};
    if (act) {
#pragma unroll
        for (int rg = 0; rg < 4; ++rg) Sl[(16 * rt + 4 * fq + rg) * 16 + fr] = zz; }
    f32x4 a_0[4], a_1[4], a_2[4], a_3[4], a_4[4], a_5[4], a_6[4], a_7[4]; f32x4 b_0, b_1, b_2, b_3, b_4, b_5, b_6, b_7;
    b_0 = b_1 = b_2 = b_3 = b_4 = b_5 = b_6 = b_7 = sreg;
#pragma unroll
    for (int q = 0; q < 4; ++q) a_0[q] = a_1[q] = a_2[q] = a_3[q] = a_4[q] = a_5[q] = a_6[q] = a_7[q] = sreg;
#define SC_LD(st, idx) do { const float* ra_ = base + (size_t)((idx) < NCH ? (idx) : NCH - 1) * GD_REC_F; b_##st = *(const f32x4*)(ra_ + boff); \
        _Pragma("unroll") for (int q = 0; q < 4; ++q) a_##st[q] = *(const f32x4*)(ra_ + aoff + q * 256); } while (0)
#define SC_STEP(st, sn, idx) do { \
        f32x4 c0_ = b_##st, c1_ = (f32x4){0.f, 0.f, 0.f, 0.f}; \
        if (act) { \
            const float* Sc_ = Sl + ((idx) & 1) * 1024; \
            asm volatile("" :: "v"(c0_[0]), "v"(c0_[3]) : "memory"); \
            *(f32x4*)(base + (size_t)(idx) * GD_REC_F + boff) = sreg; \
            _Pragma("unroll") for (int kk = 0; kk < 16; kk += 2) { \
                const float s0_ = Sc_[(4 * kk + fq) * 16 + fr], s1_ = Sc_[(4 * kk + 4 + fq) * 16 + fr]; \
                c0_ = __builtin_amdgcn_mfma_f32_16x16x4f32(a_##st[kk >> 2][kk & 3], s0_, c0_, 0, 0, 0); \
                c1_ = __builtin_amdgcn_mfma_f32_16x16x4f32(a_##st[(kk + 1) >> 2][(kk + 1) & 3], s1_, c1_, 0, 0, 0); } \
        } \
        SC_LD(sn, (idx) + 7); \
        if (act) { float* Sn_ = Sl + (((idx) + 1) & 1) * 1024; sreg = c0_ + c1_; \
            _Pragma("unroll") for (int rg = 0; rg < 4; ++rg) Sn_[(16 * rt + 4 * fq + rg) * 16 + fr] = sreg[rg]; } \
        __syncthreads(); } while (0)
    SC_LD(0, 0); SC_LD(1, 1); SC_LD(2, 2); SC_LD(3, 3); SC_LD(4, 4); SC_LD(5, 5); SC_LD(6, 6);
    __syncthreads();
#pragma unroll 1
    for (int i = 0; i < 256; i += 8) { SC_STEP(0, 7, i); SC_STEP(1, 0, i + 1); SC_STEP(2, 1, i + 2); SC_STEP(3, 2, i + 3); SC_STEP(4, 3, i + 4); SC_STEP(5, 4, i + 5); SC_STEP(6, 5, i + 6); SC_STEP(7, 6, i + 7); }
    SC_STEP(0, 7, 256); SC_STEP(1, 0, 257); SC_STEP(2, 1, 258); SC_STEP(3, 2, 259);
    static_assert(NCH == 260, "scan tail written for 260 chunks");
#undef SC_LD
#undef SC_STEP
    __syncthreads();
}
DEVI void phase_m2(const Params& p, int l, float* sm) {
    trig_tables(sm);
    if (obx() < 64) { scan_block(p, obx(), sm); return; }
    constexpr int N_F2 = 1024, N_CV = 1040, N_PX = 256, N_CF = 16, N_PC = 32;
    const int G = ogd() - 64, bx = obx() - 64;
    for (int it = bx; it < N_F2; it += G) fft2_item(p, it, sm);
    const bool lastl = (l == NLAYER - 1);
    if (M2_CONV) for (int it = (bx + 64) % G; it < (lastl ? 1024 : N_CV); it += G) conv_item(p, l, it, sm);
    if (M2_POOL) { for (int it = (bx + 32) % G; it < N_PX; it += G) poolx_item(p, it, sm);
        if (!lastl) { for (int it = bx; it < N_CF; it += G) ctxfft_item(p, it, sm);
            for (int it = (bx + 96) % G; it < N_PC; it += G) poolc_item(p, it); } }
}

DEVI void g3_item(const Params& p, int l, int item, float* sm) { unsigned char* const ws = opq(p.ws);
    const int tid = otid(); const int b = item / (4 * NCH), rem = item - b * 4 * NCH, h = rem / NCH, jc = rem - h * NCH;
    int i_f, i_b, rowbase;
    if (jc < 4) { i_f = jc; i_b = 3 - jc; rowbase = T + b * 256 + 64 * jc; } else { const int jx = jc - 4; i_f = 4 + jx; i_b = 4 + 255 - jx; rowbase = b * SEQ + 64 * jx; }
    const float* recf = (const float*)(ws + WS_GD) + (size_t)(((b * 2 + 0) * 4 + h) * NCH + i_f) * GD_REC_F;
    const float* recb = (const float*)(ws + WS_GD) + (size_t)(((b * 2 + 1) * 4 + h) * NCH + i_b) * GD_REC_F;
    float* Qf = sm; float* Sf = sm + 4352; float* Qb = sm + 8448; float* Sb = sm + 12800;
    const int rt = tid >> 5, ct = tid & 31, r0 = 4 * rt, c0 = 2 * ct;
    const bf16_t* Of = (const bf16_t*)(recf + 8192) + 4096; const bf16_t* Ob = (const bf16_t*)(recb + 8192) + 4096;
    const bf16_t* P = (const bf16_t*)(ws + WS_P); bf16_t* Y = (bf16_t*)(ws + WS_NY);
    unsigned vf[4], vb[4], zv[4];
#pragma unroll
    for (int x = 0; x < 4; ++x) { vf[x] = *(const unsigned*)(Of + (r0 + x) * 64 + c0); vb[x] = *(const unsigned*)(Ob + (63 - r0 - x) * 64 + c0);
        zv[x] = *(const unsigned*)(P + (size_t)(rowbase + r0 + x) * PPITCH + 1792 + h * 64 + c0); }
    for (int i = tid; i < 1024; i += 512) { const int r = i >> 4, c4 = (i & 15) * 4;
        { const float4 sf = *(const float4*)(recf + 4096 + i * 4), sb = *(const float4*)(recb + 4096 + i * 4);
          const int ln = i & 63, d0 = 16 * ((i >> 6) & 3) + 4 * (ln >> 4), dv = 16 * (i >> 8) + (ln & 15);
          Sf[(d0 + 0) * 64 + dv] = sf.x; Sf[(d0 + 1) * 64 + dv] = sf.y; Sf[(d0 + 2) * 64 + dv] = sf.z; Sf[(d0 + 3) * 64 + dv] = sf.w;
          Sb[(d0 + 0) * 64 + dv] = sb.x; Sb[(d0 + 1) * 64 + dv] = sb.y; Sb[(d0 + 2) * 64 + dv] = sb.z; Sb[(d0 + 3) * 64 + dv] = sb.w; }
        const uint2 qf = *(const uint2*)((const bf16_t*)(recf + 8192) + r * 64 + c4), qb = *(const uint2*)((const bf16_t*)(recb + 8192) + r * 64 + c4);
        *(float4*)(Qf + r * 68 + c4) = make_float4(__uint_as_float(qf.x << 16), __uint_as_float(qf.x & 0xFFFF0000u), __uint_as_float(qf.y << 16), __uint_as_float(qf.y & 0xFFFF0000u));
        *(float4*)(Qb + r * 68 + c4) = make_float4(__uint_as_float(qb.x << 16), __uint_as_float(qb.x & 0xFFFF0000u), __uint_as_float(qb.y << 16), __uint_as_float(qb.y & 0xFFFF0000u)); }
    __syncthreads();
    float o[4][2];
#pragma unroll
    for (int x = 0; x < 4; ++x) { o[x][0] = __uint_as_float(vf[x] << 16) + __uint_as_float(vb[x] << 16); o[x][1] = __uint_as_float(vf[x] & 0xFFFF0000u) + __uint_as_float(vb[x] & 0xFFFF0000u); }
    for (int d = 0; d < 64; d += 4) {
        float4 qf[4], qb[4];
#pragma unroll
        for (int x = 0; x < 4; ++x) { qf[x] = *(const float4*)(Qf + (r0 + x) * 68 + d); qb[x] = *(const float4*)(Qb + (63 - r0 - x) * 68 + d); }
        const float2 sf0 = *(const float2*)(Sf + (d + 0) * 64 + c0), sf1 = *(const float2*)(Sf + (d + 1) * 64 + c0), sf2 = *(const float2*)(Sf + (d + 2) * 64 + c0), sf3 = *(const float2*)(Sf + (d + 3) * 64 + c0);
        const float2 sb0 = *(const float2*)(Sb + (d + 0) * 64 + c0), sb1 = *(const float2*)(Sb + (d + 1) * 64 + c0), sb2 = *(const float2*)(Sb + (d + 2) * 64 + c0), sb3 = *(const float2*)(Sb + (d + 3) * 64 + c0);
#pragma unroll
        for (int x = 0; x < 4; ++x) {
            o[x][0] += qf[x].x * sf0.x + qf[x].y * sf1.x + qf[x].z * sf2.x + qf[x].w * sf3.x + qb[x].x * sb0.x + qb[x].y * sb1.x + qb[x].z * sb2.x + qb[x].w * sb3.x;
            o[x][1] += qf[x].x * sf0.y + qf[x].y * sf1.y + qf[x].z * sf2.y + qf[x].w * sf3.y + qb[x].x * sb0.y + qb[x].y * sb1.y + qb[x].z * sb2.y + qb[x].w * sb3.y; }
    }
    const float nw0 = inp(p, 26)[l * 64 + c0], nw1 = inp(p, 26)[l * 64 + c0 + 1];
#pragma unroll
    for (int x = 0; x < 4; ++x) { float ss = o[x][0] * o[x][0] + o[x][1] * o[x][1];
        ss += __shfl_xor(ss, 1); ss += __shfl_xor(ss, 2); ss += __shfl_xor(ss, 4); ss += __shfl_xor(ss, 8); ss += __shfl_xor(ss, 16);
        const float rs = rsqrtf(ss * (1.f / 64.f) + EPS); const size_t row = (size_t)(rowbase + r0 + x);
        const float z0 = __uint_as_float(zv[x] << 16), z1 = __uint_as_float(zv[x] & 0xFFFF0000u);
        *(unsigned*)(Y + row * YK + 1024 + h * 64 + c0) = pk2(o[x][0] * rs * nw0 * siluf(z0), o[x][1] * rs * nw1 * siluf(z1)); }
    __syncthreads();
}

DEVI void phase_final(const Params& p) {
    const int tid = otid(); const int lane = tid & 63; const int gw = obx() * 8 + (tid >> 6), ngw = ogd() * 8;
    const float4* nw4 = (const float4*)inp(p, 27);
    float4 w4[4];
#pragma unroll
    for (int q = 0; q < 4; ++q) w4[q] = nw4[lane + 64 * q];
    float* const ob = outp(p);
    float4 v[4];
    if (gw < T) {
#pragma unroll
        for (int q = 0; q < 4; ++q) v[q] = ((const float4*)(ob + (size_t)gw * D))[lane + 64 * q]; }
    for (int row = gw; row < T; row += ngw) {
        float4* r4 = (float4*)(ob + (size_t)row * D);
        const int lrow = row + ngw < T ? row + ngw : row;
        const float4* n4 = (const float4*)(ob + (size_t)lrow * D);
        float4 nx[4];
#pragma unroll
        for (int q = 0; q < 4; ++q) nx[q] = n4[lane + 64 * q];
        float ss = 0.f;
#pragma unroll
        for (int q = 0; q < 4; ++q) ss += v[q].x * v[q].x + v[q].y * v[q].y + v[q].z * v[q].z + v[q].w * v[q].w;
        ss = wave_sum(ss); const float rs = rsqrtf(ss * (1.f / 1024.f) + EPS);
#pragma unroll
        for (int q = 0; q < 4; ++q) r4[lane + 64 * q] = make_float4(v[q].x * rs * w4[q].x, v[q].y * rs * w4[q].y, v[q].z * rs * w4[q].z, v[q].w * rs * w4[q].w);
#pragma unroll
        for (int q = 0; q < 4; ++q) v[q] = nx[q];
    }
}

#define XB_TMO      128
#define XB_XCNT(j)  (256  + 64 * (j))
#define XB_XSUB(j)  (1280 + 64 * (j))
#define XB_XGEN(j)  (2304 + 64 * (j))
#define XB_TOP      3328
#define XB_TOPGEN   3392
#define XCD_BAR_WORDS 3456
#define XB_SPIN_CAP (1u << 18)
#define LAS __attribute__((address_space(3)))

__device__ __forceinline__ unsigned xb_ld(unsigned* p)              { return __hip_atomic_load(p, __ATOMIC_RELAXED, __HIP_MEMORY_SCOPE_AGENT); }
__device__ __forceinline__ unsigned xb_add(unsigned* p, unsigned v) { return __hip_atomic_fetch_add(p, v, __ATOMIC_RELAXED, __HIP_MEMORY_SCOPE_AGENT); }
__device__ __forceinline__ unsigned xb_xcc_id() { return (unsigned)__builtin_amdgcn_s_getreg((3 << 11) | 20) & 0xFu; }
#define XB_SPIN(cond, bar) do { unsigned _sp = 0; while (cond) { __builtin_amdgcn_s_sleep(1); \
    if ((++_sp & 255u) == 0u) { if (xb_ld(&(bar)[XB_TMO])) break; if (_sp > XB_SPIN_CAP) { atomicAdd(&(bar)[XB_TMO], 1u); break; } } } } while (0)

struct XcdBarrier {
    unsigned* bar; unsigned x;
    volatile LAS unsigned* st;
};

__device__ __forceinline__ XcdBarrier xcd_barrier_post(unsigned* bar, volatile LAS unsigned* st) {
    XcdBarrier b; b.bar = bar; b.x = xb_xcc_id(); b.st = st;
    if (threadIdx.x == 0) (void)xb_add(&bar[XB_XCNT(b.x)], 1u);
    return b;
}
__device__ __forceinline__ void xcd_barrier_complete(unsigned* bar, unsigned x, unsigned& nloc, unsigned& nx) {
    const unsigned G = gridDim.x * gridDim.y * gridDim.z;
    unsigned sum, cnt, mine, sp = 0u;
    for (;;) {
        sum = 0u; cnt = 0u; mine = 0u;
#pragma unroll
        for (unsigned j = 0; j < 16; ++j) { const unsigned c = xb_ld(&bar[XB_XCNT(j)]); sum += c; cnt += (c > 0u) ? 1u : 0u; mine = (j == x) ? c : mine; }
        if (sum == G) break;
        __builtin_amdgcn_s_sleep(1);
        if ((++sp & 255u) == 0u) { if (xb_ld(&bar[XB_TMO])) break; if (sp > XB_SPIN_CAP) { atomicAdd(&bar[XB_TMO], 1u); break; } }
    }
    nloc = mine > 0u ? mine : 1u; nx = cnt > 0u ? cnt : 1u;
}

__device__ __forceinline__ void xcd_barrier(const XcdBarrier& b) {
    asm volatile("s_waitcnt vmcnt(0)" ::: "memory");
    __syncthreads();
    if (threadIdx.x == 0) {
        unsigned* bar = b.bar;
        __builtin_amdgcn_s_waitcnt(0);
        unsigned nloc = b.st[0], nx = b.st[1];
        if (nloc == 0u) { xcd_barrier_complete(bar, b.x, nloc, nx); b.st[0] = nloc; b.st[1] = nx; }
        const unsigned old = xb_add(&bar[XB_XSUB(b.x)], 1u);
        const unsigned gen = old / nloc;
        if (old + 1u == (gen + 1u) * nloc) {
            __builtin_amdgcn_fence(__ATOMIC_RELEASE, "agent");
            asm volatile("s_waitcnt vmcnt(0)" ::: "memory");
            const unsigned og = xb_add(&bar[XB_TOP], 1u);
            const unsigned tg = og / nx;
            if (og + 1u == (tg + 1u) * nx) xb_add(&bar[XB_TOPGEN], 1u);
            else XB_SPIN(xb_ld(&bar[XB_TOPGEN]) == tg, bar);
            __builtin_amdgcn_fence(__ATOMIC_ACQUIRE, "agent");
            xb_add(&bar[XB_XGEN(b.x)], 1u);
            asm volatile("s_waitcnt vmcnt(0)" ::: "memory");
        } else {
            XB_SPIN(xb_ld(&bar[XB_XGEN(b.x)]) == gen, bar);
            __builtin_amdgcn_fence(__ATOMIC_ACQUIRE, "agent");
            asm volatile("s_waitcnt vmcnt(0)" ::: "memory");
        }
    }
    __syncthreads();
}


#ifndef MK_ALIGN
#define MK_ALIGN true
#endif
#ifndef MK_SP2
#define MK_SP2 true
#endif
constexpr int N_PHASES = 2 + 12 * NLAYER;
__global__ void __launch_bounds__(512, 2) mega_fwd(Params p) {
    extern __shared__ __attribute__((aligned(16))) unsigned char lds[];
    float* sm = (float*)lds;
    PG8_LAS unsigned char* glds = (PG8_LAS unsigned char*)lds;
    cg::grid_group grid = cg::this_grid();
    volatile LAS unsigned* xst = (volatile LAS unsigned*)(lds + LDS_BYTES - 16);
    if (threadIdx.x == 0) { xst[0] = 0u; xst[1] = 0u; }
    __syncthreads();
    const XcdBarrier xb = xcd_barrier_post((unsigned*)(p.ws + WS_BAR), xst);
    pg8::StaticOrder S;
    int rep_done = 0;
#pragma unroll 1
    for (int ph = p.ph_lo; ph < p.ph_hi; ++ph) {
        unsigned char* const ws = opq(p.ws);
        if (ph == 0) { if (!(SKIPM & 1)) phase_init(p, sm); }
        else if (ph == N_PHASES - 1) phase_final(p);
        else {
            const int l = (ph - 1) / 12, s = (ph - 1) % 12;
            if (s == 3 || s == 9) continue;
            const float* MODL = (const float*)(ws + WS_MOD) + (size_t)l * 3 * 9216;
            switch (s) {
            case 0: if (!(SKIPM & 2)) phase_prep(p, l, sm); break;
            case 1: case 10: if (!(SKIPM & 4)) {
                const int Mup = (s == 10 && l == NLAYER - 1) ? T : MROWS;
                S.init(Mup, 2 * FH, ogd(), obx());
                pg8::Gemm g{(const bf16_t*)(ws + (s == 1 ? WS_NY : WS_GD)), (const bf16_t*)(ws + (s == 1 ? WS_WUP1 : WS_WUP2)), Mup, 2 * FH, 1024};
                EpiUp E{(bf16_t*)(ws + WS_H), (const float*)(ws + WS_RS + (s == 1 ? 0 : 2) * RS_STRIDE), (const float*)(ws + WS_BIAS) + (size_t)(s == 1 ? 0 : 2) * 3 * 5632};
                pg8::gemm_phase<decltype(E), pg8::StaticOrder, MK_ALIGN, MK_SP2>(glds, g, S, E); } break;
            case 2: case 8: case 11: if (!(SKIPM & 8)) {
                const int K = s == 8 ? YK : FH;
                const bf16_t* A = (const bf16_t*)(ws + (s == 8 ? WS_NY : WS_H)); const bf16_t* W = (const bf16_t*)(ws + (s == 2 ? WS_WDN1 : s == 8 ? WS_WOUT : WS_WDN2));
                const float* gate = MODL + (s == 2 ? 2 : s == 8 ? 5 : 8) * 1024; const float mult = s == 8 ? 1.f : 0.5f;
                S.init(T, 1024, ogd(), obx());
                pg8::Gemm g{A, W, T, 1024, K};
                const bool feeds = !(s == 11 && l == NLAYER - 1);
                bf16_t* nyraw = feeds ? (bf16_t*)(ws + (s == 8 ? WS_GD : WS_NY)) : nullptr; float* rsacc = (float*)(ws + WS_RS + (s == 2 ? 1 : s == 8 ? 2 : 0) * RS_STRIDE);
                const int nl = s == 11 ? l + 1 : l, nwhich = s == 2 ? 1 : s == 8 ? 2 : 0;
                const float* nw = inp(p, 6) + ((size_t)(feeds ? nl : l) * 3 + nwhich) * 1024; const float* nscale = (const float*)(ws + WS_MOD) + (size_t)(feeds ? nl : l) * 3 * 9216 + (3 * nwhich + 1) * 1024;
                const bool first = (l == 0 && s == 2);
                const EpiRes E{outp(p), (float*)(ws + WS_CTXR), first ? inp(p, 0) : (const float*)outp(p), gate, nyraw, rsacc, nw, nscale, mult, feeds ? 1 : 0};
                pg8::gemm_phase<decltype(E), pg8::StaticOrder, MK_ALIGN, MK_SP2>(glds, g, S, E);
                if (!(l == NLAYER - 1 && s != 2)) mini_res(p, A, W, K, gate, mult, nyraw, rsacc, nw, nscale, first ? inp(p, 2) : (const float*)(ws + WS_CTXR), sm); } break;
            case 4: if (!(SKIPM & 16)) {
                S.init(MROWS, PN, ogd(), obx());
                pg8::Gemm g{(const bf16_t*)(ws + WS_NY), (const bf16_t*)(ws + WS_WIN), MROWS, PN, 1024};
                EpiP E{(bf16_t*)(ws + WS_P), (const float*)(ws + WS_RS + RS_STRIDE), (const float*)(ws + WS_BIAS) + (size_t)3 * 5632};
                pg8::gemm_phase<decltype(E), pg8::StaticOrder, MK_ALIGN, MK_SP2>(glds, g, S, E);
                { float* RS0 = (float*)(ws + WS_RS); float* RS2 = (float*)(ws + WS_RS + 2 * RS_STRIDE);
                  for (int i = obx() * 512 + otid(); i < MROWS; i += ogd() * 512) { RS0[i] = 0.f; RS2[i] = 0.f; } } } break;
            case 5: if (!(SKIPM & 32)) phase_m1(p, l, sm); break;
            case 6: if (!(SKIPM & 64)) phase_m2(p, l, sm); break;
            case 7: if (!(SKIPM & 128)) {
                if (l == NLAYER - 1) { for (int it = obx(); it < 2048; it += ogd()) g3_item(p, l, (it >> 8) * NCH + 4 + (it & 255), sm); }
                else for (int it = obx(); it < 2 * 4 * NCH; it += ogd()) g3_item(p, l, it, sm); } break;
            }
        }
#if REPM
        {
            const int s_ = (ph >= 1 && ph < N_PHASES - 1) ? (ph - 1) % 12 : -1;
            if (s_ >= 0) {
                if (((REPM >> s_) & 1) && s_ != 6) { if (!rep_done) { rep_done = 1; --ph; } else rep_done = 0; }
                if ((REPM & 4096) && s_ == 6) { if (!rep_done) { rep_done = 1; ph -= 2; } else rep_done = 0; }
            }
        }
#endif
        if (ph + 1 < p.ph_hi) { if (p.ph_lo < 0) grid.sync(); else xcd_barrier(xb); }
    }
}

#ifndef MK_PER_PHASE
#define MK_PER_PHASE 0
#endif
extern "C" void kernel_launch(void* const* d_in, const int* in_sizes, int n_in, void* d_out, int out_size, void* d_ws, size_t ws_size, hipStream_t stream) {
    static int grid = 0;
    if (grid == 0) {
        if (n_in != 28 || out_size != T * D || ws_size < WS_TOTAL) { fprintf(stderr, "kernel_launch: unexpected shapes (n_in %d, out %d, ws %zu < %zu)\n", n_in, out_size, ws_size, (size_t)WS_TOTAL); grid = -1; return; }
        int dev = 0, cus = 0, per_cu = 0;
        (void)hipGetDevice(&dev); (void)hipDeviceGetAttribute(&cus, hipDeviceAttributeMultiprocessorCount, dev);
        if (hipFuncSetAttribute((const void*)mega_fwd, hipFuncAttributeMaxDynamicSharedMemorySize, LDS_BYTES) != hipSuccess) { fprintf(stderr, "kernel_launch: hipFuncSetAttribute failed\n"); grid = -1; return; }
        if (hipOccupancyMaxActiveBlocksPerMultiprocessor(&per_cu, (const void*)mega_fwd, 512, LDS_BYTES) != hipSuccess || per_cu < 1) { fprintf(stderr, "kernel_launch: occupancy query says %d\n", per_cu); per_cu = 1; }
        (void)hipGetLastError();
        grid = cus * 1;
        if (grid < 128) { fprintf(stderr, "kernel_launch: %d CUs?\n", grid); grid = -1; return; }
    }
    if (grid < 0) return;
    Params p{};
    for (int i = 0; i < 28; ++i) p.in[i] = (const float*)d_in[i];
    p.out = (float*)d_out; p.ws = (unsigned char*)d_ws;
#if MK_PER_PHASE
    for (int ph = 0; ph < N_PHASES; ++ph) { p.ph_lo = ph; p.ph_hi = ph + 1; hipLaunchKernelGGL(mega_fwd, dim3(grid), dim3(512), LDS_BYTES, stream, p); }
#else
    p.ph_lo = 0; p.ph_hi = N_PHASES;
    (void)hipMemsetAsync((unsigned char*)d_ws + WS_BAR, 0, XCD_BAR_WORDS * sizeof(unsigned), stream);
    void* args[] = {&p};
    const hipError_t e = hipLaunchCooperativeKernel((const void*)mega_fwd, dim3(grid), dim3(512), args, LDS_BYTES, stream);
    if (e != hipSuccess) fprintf(stderr, "kernel_launch: cooperative launch failed: %s (grid %d)\n", hipGetErrorString(e), grid);
#endif
}
```
